# Optimizing an MI355X kernel written in HIP

```python
import math
import jax
import jax.numpy as jnp
from jax import lax
import numpy as np

D_MODEL = 2048
BATCH = 2
SEQ = 8192
DEPTH = 1

CHUNK = 64
EPS = 1e-6
D_SSM = D_MODEL // 2
SSM_GROUP_CH = 16
N_SSM_GROUPS = D_SSM // SSM_GROUP_CH
SSM_STATE = 64
DT_MIN = 1e-3
DT_MAX = 1e-1
LAMBDA_RE_MAX = -1e-4
QK_NOPE = 128
QK_ROPE = 64
QK_DIM = QK_NOPE + QK_ROPE
V_HEAD = 128
MLA_HEADS = (D_MODEL // 2) // V_HEAD
Q_LORA = D_MODEL // 4
KV_LORA = D_MODEL // 8
ROPE_THETA = 10000.0
Q_BLOCK = 128
SPLIT_POINTS = (D_SSM, D_SSM + Q_LORA, D_SSM + Q_LORA + KV_LORA, D_SSM + Q_LORA + KV_LORA + QK_ROPE, D_SSM + Q_LORA + KV_LORA + QK_ROPE + D_MODEL)
D_IN = D_SSM + Q_LORA + KV_LORA + QK_ROPE + 2 * D_MODEL
N_EXPERTS = 64
TOP_K = 8
N_EXPERT_GROUPS = 8
TOPK_GROUPS = 4
D_EXPERT = D_MODEL // 4
D_SHARED = D_MODEL // 4
ROUTED_SCALE = 2.5
MOE_BLOCK = 128

kernel_name = 'hybrid_s5_mla_moe_block'


def rms_norm(x, g):
    xf = x.astype(jnp.float32)
    y = xf * lax.rsqrt(jnp.mean(xf * xf, axis=-1, keepdims=True) + EPS)
    return (y * g.astype(jnp.float32)).astype(x.dtype)


def _complex_affine_combine(e1, e2):
    a1r, a1i, b1r, b1i = e1
    a2r, a2i, b2r, b2i = e2
    return (a1r * a2r - a1i * a2i,
            a1r * a2i + a1i * a2r,
            a2r * b1r - a2i * b1i + b2r,
            a2r * b1i + a2i * b1r + b2i)


def s5_mixer(u, a_re, a_im, log_dt, b_re, b_im, c_re, c_im, d):
    f32 = jnp.float32
    bn, s_len, _ = u.shape
    uf = u.astype(f32).reshape(bn, s_len, N_SSM_GROUPS, SSM_GROUP_CH)
    dt = jnp.exp(log_dt.astype(f32))[:, None]
    lam_re = jnp.minimum(a_re.astype(f32), LAMBDA_RE_MAX)
    lam_im = a_im.astype(f32)
    mag = jnp.exp(lam_re * dt)
    ang = lam_im * dt
    lb_re = mag * jnp.cos(ang)
    lb_im = mag * jnp.sin(ang)
    den = lam_re * lam_re + lam_im * lam_im
    num_re = lb_re - 1.0
    coef_re = (num_re * lam_re + lb_im * lam_im) / den
    coef_im = (lb_im * lam_re - num_re * lam_im) / den
    br = b_re.astype(f32)
    bi = b_im.astype(f32)
    bb_re = coef_re[..., None] * br - coef_im[..., None] * bi
    bb_im = coef_re[..., None] * bi + coef_im[..., None] * br
    bu_re = jnp.einsum('bsgc,gnc->bsgn', uf, bb_re)
    bu_im = jnp.einsum('bsgc,gnc->bsgn', uf, bb_im)
    a_seq_re = jnp.broadcast_to(lb_re, (1, s_len, N_SSM_GROUPS, SSM_STATE))
    a_seq_im = jnp.broadcast_to(lb_im, (1, s_len, N_SSM_GROUPS, SSM_STATE))
    _, _, st_re, st_im = lax.associative_scan(_complex_affine_combine, (a_seq_re, a_seq_im, bu_re, bu_im), axis=1)
    y = (jnp.einsum('bsgn,gcn->bsgc', st_re, c_re.astype(f32))
         - jnp.einsum('bsgn,gcn->bsgc', st_im, c_im.astype(f32))
         + d.astype(f32).reshape(N_SSM_GROUPS, SSM_GROUP_CH) * uf)
    return jax.nn.gelu(y).reshape(bn, s_len, D_SSM).astype(u.dtype)


def rope_cos_sin(positions):
    inv = ROPE_THETA ** (-jnp.arange(QK_ROPE // 2, dtype=jnp.float32) * (2.0 / QK_ROPE))
    ang = positions.astype(jnp.float32)[..., None] * inv
    return jnp.cos(ang)[:, :, None, :], jnp.sin(ang)[:, :, None, :]


def apply_rope(x, cos, sin):
    xf = x.astype(jnp.float32)
    half = QK_ROPE // 2
    x1, x2 = xf[..., :half], xf[..., half:]
    return jnp.concatenate([x1 * cos - x2 * sin, x2 * cos + x1 * sin], axis=-1).astype(x.dtype)


def mla_mixer(q_lat, kv_lat, k_pe, positions, q_lat_g, w_q_up, kv_lat_g, w_kv_up, q_norm_g, k_norm_g):
    bn, s_len, _ = q_lat.shape
    q = (rms_norm(q_lat, q_lat_g) @ w_q_up).reshape(bn, s_len, MLA_HEADS, QK_DIM)
    kv = (rms_norm(kv_lat, kv_lat_g) @ w_kv_up).reshape(bn, s_len, MLA_HEADS, QK_NOPE + V_HEAD)
    k_nope, v = kv[..., :QK_NOPE], kv[..., QK_NOPE:]
    k = jnp.concatenate([k_nope, jnp.broadcast_to(k_pe[:, :, None, :], (bn, s_len, MLA_HEADS, QK_ROPE))], axis=-1)
    q = rms_norm(q, q_norm_g)
    k = rms_norm(k, k_norm_g)
    cos, sin = rope_cos_sin(positions)
    q = jnp.concatenate([q[..., :QK_NOPE], apply_rope(q[..., QK_NOPE:], cos, sin)], axis=-1)
    k = jnp.concatenate([k[..., :QK_NOPE], apply_rope(k[..., QK_NOPE:], cos, sin)], axis=-1)
    q = q * jnp.asarray(QK_DIM ** -0.5, q.dtype)
    n_blk = s_len // Q_BLOCK
    q_blocks = q.reshape(bn, n_blk, Q_BLOCK, MLA_HEADS, QK_DIM).transpose(1, 0, 2, 3, 4)
    key_chunk = jnp.arange(s_len) // CHUNK

    def attend(args):
        q_blk, blk = args
        s = jnp.einsum('bqhd,bkhd->bhqk', q_blk, k, preferred_element_type=jnp.float32)
        q_chunk = (blk * Q_BLOCK + jnp.arange(Q_BLOCK)) // CHUNK
        mask = key_chunk[None, :] <= q_chunk[:, None]
        p = jax.nn.softmax(jnp.where(mask, s, -jnp.inf), axis=-1)
        return jnp.einsum('bhqk,bkhd->bqhd', p.astype(v.dtype), v)

    o = lax.map(attend, (q_blocks, jnp.arange(n_blk)))
    return o.transpose(1, 0, 2, 3, 4).reshape(bn, s_len, MLA_HEADS * V_HEAD)


def routed_experts(hf, top_e, top_w, w_exp_gate, w_exp_up, w_exp_down):
    t, _ = hf.shape
    n_assign = t * TOP_K
    n_blk = -(-n_assign // MOE_BLOCK) + N_EXPERTS
    buf_len = n_blk * MOE_BLOCK
    flat_e = top_e.reshape(-1)
    flat_tok = jnp.repeat(jnp.arange(t, dtype=jnp.int32), TOP_K)
    flat_w = top_w.reshape(-1)
    order = jnp.argsort(flat_e)
    sorted_e = flat_e[order]
    counts = jnp.bincount(flat_e, length=N_EXPERTS)
    start = jnp.cumsum(counts) - counts
    padded = (counts + MOE_BLOCK - 1) // MOE_BLOCK * MOE_BLOCK
    pad_end = jnp.cumsum(padded)
    pad_start = pad_end - padded
    dest = pad_start[sorted_e] + jnp.arange(n_assign) - start[sorted_e]
    tok_buf = jnp.zeros((buf_len,), jnp.int32).at[dest].set(flat_tok[order])
    w_buf = jnp.zeros((buf_len,), jnp.float32).at[dest].set(flat_w[order])
    blk_expert = jnp.minimum(jnp.searchsorted(pad_end, jnp.arange(n_blk) * MOE_BLOCK, side='right'), N_EXPERTS - 1)

    def step(acc, inp):
        tok, w, e = inp
        xb = hf[tok]
        hid = jax.nn.silu(xb @ w_exp_gate[e]) * (xb @ w_exp_up[e])
        y = (hid @ w_exp_down[e]) * w[:, None].astype(hf.dtype)
        return acc.at[tok].add(y), None

    acc, _ = lax.scan(step, jnp.zeros_like(hf), (tok_buf.reshape(n_blk, MOE_BLOCK), w_buf.reshape(n_blk, MOE_BLOCK), blk_expert))
    return acc


def moe(h, w_router, router_bias, w_exp_gate, w_exp_up, w_exp_down, w_sh_gate, w_sh_up, w_sh_down):
    bn, s_len, d = h.shape
    t = bn * s_len
    hf = h.reshape(t, d)
    shared = (jax.nn.silu(hf @ w_sh_gate) * (hf @ w_sh_up)) @ w_sh_down
    scores = jax.nn.sigmoid(hf.astype(jnp.float32) @ w_router.astype(jnp.float32))
    sel = scores + router_bias.astype(jnp.float32)
    per_grp = N_EXPERTS // N_EXPERT_GROUPS
    grp_score = lax.top_k(sel.reshape(t, N_EXPERT_GROUPS, per_grp), 2)[0].sum(-1)
    _, top_grp = lax.top_k(grp_score, TOPK_GROUPS)
    grp_mask = jax.nn.one_hot(top_grp, N_EXPERT_GROUPS, dtype=jnp.float32).sum(1) > 0
    exp_mask = jnp.repeat(grp_mask, per_grp, axis=1)
    _, top_e = lax.top_k(jnp.where(exp_mask, sel, -jnp.inf), TOP_K)
    top_w = jnp.take_along_axis(scores, top_e, axis=1)
    top_w = top_w / jnp.sum(top_w, axis=-1, keepdims=True) * ROUTED_SCALE
    routed = routed_experts(hf, top_e, top_w, w_exp_gate, w_exp_up, w_exp_down)
    return (shared + routed).reshape(bn, s_len, d)


def hybrid_layer(x, positions, norm1_g, w_in, q_lat_g, w_q_up, kv_lat_g, w_kv_up, q_norm_g, k_norm_g,
                 ssm_a_re, ssm_a_im, ssm_log_dt, ssm_b_re, ssm_b_im, ssm_c_re, ssm_c_im, ssm_d,
                 w_ssm_val, w_ssm_gate, w_mla_proj, w_out, norm2_g, w_router, router_bias,
                 w_exp_gate, w_exp_up, w_exp_down, w_sh_gate, w_sh_up, w_sh_down):
    h = rms_norm(x, norm1_g)
    proj = h @ w_in
    u, q_lat, kv_lat, k_pe, g_ssm, g_mla = jnp.split(proj, SPLIT_POINTS, axis=-1)
    y_ssm = s5_mixer(u, ssm_a_re, ssm_a_im, ssm_log_dt, ssm_b_re, ssm_b_im, ssm_c_re, ssm_c_im, ssm_d)
    ssm_branch = (y_ssm @ w_ssm_val) * jax.nn.sigmoid(y_ssm @ w_ssm_gate)
    mla_branch = mla_mixer(q_lat, kv_lat, k_pe, positions, q_lat_g, w_q_up, kv_lat_g, w_kv_up, q_norm_g, k_norm_g) @ w_mla_proj
    merged = jax.nn.sigmoid(g_ssm) * ssm_branch + jax.nn.sigmoid(g_mla) * mla_branch
    x = x + merged @ w_out
    h2 = rms_norm(x, norm2_g)
    return x + moe(h2, w_router, router_bias, w_exp_gate, w_exp_up, w_exp_down, w_sh_gate, w_sh_up, w_sh_down)


def setup_inputs(seed: int = 0) -> dict:
    key = jax.random.key(seed)
    f32 = jnp.float32

    def nk(i):
        return jax.random.fold_in(key, i)

    def dense(i, shape, fan_in):
        return jax.random.normal(nk(i), (DEPTH,) + shape, f32) * fan_in ** -0.5

    def gain(i, n):
        return 1.0 + 0.02 * jax.random.normal(nk(i), (DEPTH, n), f32)

    g, n, c = N_SSM_GROUPS, SSM_STATE, SSM_GROUP_CH
    return {
        'x': jax.random.normal(nk(0), (BATCH, SEQ, D_MODEL), f32),
        'positions': jnp.broadcast_to(jnp.arange(SEQ, dtype=jnp.int32), (BATCH, SEQ)),
        'norm1_g': gain(1, D_MODEL),
        'w_in': dense(2, (D_MODEL, D_IN), D_MODEL),
        'q_lat_g': gain(3, Q_LORA),
        'w_q_up': dense(4, (Q_LORA, MLA_HEADS * QK_DIM), Q_LORA),
        'kv_lat_g': gain(5, KV_LORA),
        'w_kv_up': dense(6, (KV_LORA, MLA_HEADS * (QK_NOPE + V_HEAD)), KV_LORA),
        'q_norm_g': gain(7, QK_DIM),
        'k_norm_g': gain(8, QK_DIM),
        'ssm_a_re': -0.5 + 0.01 * jax.random.normal(nk(9), (DEPTH, g, n), f32),
        'ssm_a_im': math.pi * jnp.arange(n, dtype=f32) + 0.01 * jax.random.normal(nk(10), (DEPTH, g, n), f32),
        'ssm_log_dt': jax.random.uniform(nk(11), (DEPTH, g), f32, math.log(DT_MIN), math.log(DT_MAX)),
        'ssm_b_re': dense(12, (g, n, c), 2 * c),
        'ssm_b_im': dense(13, (g, n, c), 2 * c),
        'ssm_c_re': dense(14, (g, c, n), 2 * n),
        'ssm_c_im': dense(15, (g, c, n), 2 * n),
        'ssm_d': jax.random.normal(nk(16), (DEPTH, D_SSM), f32),
        'w_ssm_val': dense(17, (D_SSM, D_MODEL), D_SSM),
        'w_ssm_gate': dense(18, (D_SSM, D_MODEL), D_SSM),
        'w_mla_proj': dense(19, (MLA_HEADS * V_HEAD, D_MODEL), MLA_HEADS * V_HEAD),
        'w_out': dense(20, (D_MODEL, D_MODEL), D_MODEL),
        'norm2_g': gain(21, D_MODEL),
        'w_router': dense(22, (D_MODEL, N_EXPERTS), D_MODEL),
        'router_bias': 0.01 * jax.random.normal(nk(23), (DEPTH, N_EXPERTS), f32),
        'w_exp_gate': dense(24, (N_EXPERTS, D_MODEL, D_EXPERT), D_MODEL),
        'w_exp_up': dense(25, (N_EXPERTS, D_MODEL, D_EXPERT), D_MODEL),
        'w_exp_down': dense(26, (N_EXPERTS, D_EXPERT, D_MODEL), D_EXPERT),
        'w_sh_gate': dense(27, (D_MODEL, D_SHARED), D_MODEL),
        'w_sh_up': dense(28, (D_MODEL, D_SHARED), D_MODEL),
        'w_sh_down': dense(29, (D_SHARED, D_MODEL), D_SHARED),
    }


def reference(x, positions, norm1_g, w_in, q_lat_g, w_q_up, kv_lat_g, w_kv_up, q_norm_g, k_norm_g,
              ssm_a_re, ssm_a_im, ssm_log_dt, ssm_b_re, ssm_b_im, ssm_c_re, ssm_c_im, ssm_d,
              w_ssm_val, w_ssm_gate, w_mla_proj, w_out, norm2_g, w_router, router_bias,
              w_exp_gate, w_exp_up, w_exp_down, w_sh_gate, w_sh_up, w_sh_down):
    layer_params = (norm1_g, w_in, q_lat_g, w_q_up, kv_lat_g, w_kv_up, q_norm_g, k_norm_g,
                    ssm_a_re, ssm_a_im, ssm_log_dt, ssm_b_re, ssm_b_im, ssm_c_re, ssm_c_im, ssm_d,
                    w_ssm_val, w_ssm_gate, w_mla_proj, w_out, norm2_g, w_router, router_bias,
                    w_exp_gate, w_exp_up, w_exp_down, w_sh_gate, w_sh_up, w_sh_down)
    for layer in range(DEPTH):
        x = hybrid_layer(x, positions, *[p[layer] for p in layer_params])
    return x
```

```cpp
#include <hip/hip_runtime.h>
#include <hip/hip_cooperative_groups.h>
#include <cstdio>
#include <cmath>
namespace cg = cooperative_groups;

#define LAS __attribute__((address_space(3)))
#define DI __device__ __forceinline__
#define CAS __attribute__((address_space(4)))
typedef unsigned short bf16_t;
typedef short bf16x8 __attribute__((ext_vector_type(8)));
typedef float f32x16 __attribute__((ext_vector_type(16)));
typedef float f32x4 __attribute__((ext_vector_type(4)));
typedef float f32x2 __attribute__((ext_vector_type(2)));
typedef unsigned u32x4 __attribute__((ext_vector_type(4)));
typedef unsigned u32x2 __attribute__((ext_vector_type(2)));
typedef __bf16 bf16v2 __attribute__((ext_vector_type(2)));

constexpr int T = 16384, SEQ = 8192, NB = 2, D = 2048;
constexpr int DSSM = 1024, NG = 64, GC = 16, NS = 64;
constexpr int QL = 512, KVL = 256, NH = 8, QKD = 192, VD = 128;
constexpr int DINP = 6144;
constexpr int NE = 64, TOPK = 8, DE = 512;
constexpr float EPS = 1e-6f;
constexpr int NTHREADS = 512;
constexpr int LDS_BYTES = 143360;
constexpr int UT_OFF = 141312;
constexpr int SEGLEN = 256, NSEG = SEQ / SEGLEN;

constexpr size_t al(size_t x) { return (x + 255) & ~(size_t)255; }
constexpr size_t OFF_CNT   = 0;
constexpr size_t OFF_BAR   = 16384;
constexpr size_t OFF_RSTD1 = 4096 + 16384;
constexpr size_t OFF_QSS   = al(OFF_RSTD1 + (size_t)T * 4);
constexpr size_t OFF_KSS   = al(OFF_QSS + (size_t)T * 16 * 4);
constexpr size_t OFF_SSQ2  = al(OFF_KSS + (size_t)T * 8 * 4);
constexpr size_t OFF_RSTD2 = al(OFF_SSQ2 + (size_t)T * 64 * 4);
constexpr size_t OFF_RS2   = al(OFF_RSTD2 + (size_t)T * 4);
constexpr size_t OFF_KPE   = al(OFF_RS2 + (size_t)NE * T * 4);
constexpr size_t OFF_CS    = al(OFF_KPE + (size_t)T * 64 * 4);
constexpr size_t OFF_LB    = al(OFF_CS + (size_t)T * 64 * 4);
constexpr size_t OFF_LBP   = al(OFF_LB + (size_t)NG * NS * 8);
constexpr size_t OFF_BB    = al(OFF_LBP + (size_t)NG * NS * 8);
constexpr size_t OFF_CM    = al(OFF_BB + (size_t)NG * 128 * 16 * 2);
constexpr size_t OFF_EST   = al(OFF_CM + (size_t)NG * 16 * 128 * 2);
constexpr size_t OFF_WRT   = al(OFF_EST + (size_t)NB * NG * NSEG * NS * 8);
constexpr size_t OFF_LIST  = al(OFF_WRT + (size_t)D * NE * 4);
constexpr size_t OFF_ROWW  = al(OFF_LIST + (size_t)NE * T * 4);
constexpr size_t OFF_TPOS  = al(OFF_ROWW + (size_t)NE * T * 4);
constexpr size_t OFF_WIN   = al(OFF_TPOS + (size_t)T * 8 * 4);
constexpr size_t OFF_WQUP  = al(OFF_WIN + (size_t)DINP * D * 2);
constexpr size_t OFF_WKVUP = al(OFF_WQUP + (size_t)1536 * 512 * 2);
constexpr size_t OFF_WVG   = al(OFF_WKVUP + (size_t)2048 * 256 * 2);
constexpr size_t OFF_WMLA  = al(OFF_WVG + (size_t)4096 * 1024 * 2);
constexpr size_t OFF_WOUT  = al(OFF_WMLA + (size_t)2048 * 1024 * 2);
constexpr size_t OFF_WDN8  = al(OFF_WOUT + (size_t)2048 * 2048 * 2);
constexpr size_t OFF_X1F8  = al(OFF_WDN8 + (size_t)65 * 2048 * 512);
constexpr size_t OFF_HID8  = al(OFF_X1F8 + (size_t)T * D);
constexpr size_t HID_ROWS  = (size_t)T * TOPK + T;
constexpr size_t OFF_SPAN  = al(OFF_HID8 + HID_ROWS * DE);
constexpr size_t OFF_WGU8  = OFF_SPAN;
constexpr size_t OFF_U     = al(OFF_WGU8 + (size_t)65 * 1024 * 2048);
constexpr size_t OFF_QLAT  = al(OFF_U + (size_t)T * 1024 * 2);
constexpr size_t OFF_KVLAT = al(OFF_QLAT + (size_t)T * 512 * 2);
constexpr size_t OFF_SG    = al(OFF_KVLAT + (size_t)T * 256 * 2);
constexpr size_t OFF_Q     = al(OFF_SG + (size_t)T * 4096 * 2);
constexpr size_t OFF_K     = al(OFF_Q + (size_t)T * NH * QKD * 2);
constexpr size_t OFF_VT    = al(OFF_K + (size_t)T * NH * QKD * 2);
constexpr size_t OFF_XB    = al(OFF_VT + (size_t)T * NH * VD * 2);
constexpr size_t OFF_YSSM  = al(OFF_XB + (size_t)T * D * 2);
constexpr size_t OFF_ATT   = al(OFF_YSSM + (size_t)T * 1024 * 2);
constexpr size_t OFF_MRG   = al(OFF_ATT + (size_t)T * 1024 * 2);
constexpr size_t WS_END    = al(OFF_MRG + (size_t)T * D * 2);
constexpr size_t OFF_Y     = OFF_SPAN;
constexpr size_t OFF_X8    = OFF_MRG;
constexpr size_t OFF_WIN8  = OFF_WIN + (size_t)2048 * D * 2;
constexpr size_t OFF_TMP   = OFF_Q;
constexpr size_t WS_NEED = (OFF_Y + HID_ROWS * D > WS_END) ? OFF_Y + HID_ROWS * D : WS_END;
static_assert(OFF_Y + HID_ROWS * D <= WS_END, "Y overlay inside the span");
static_assert(OFF_TMP + (size_t)T * D * 2 <= OFF_VT, "TMP inside Q|K");
static_assert(WS_NEED <= (size_t)1073741824, "workspace budget");
constexpr float WSCALE = 64.0f, HSCALE = 8.0f, YSCALE = 32.0f, SSCALE = 16.0f, XSCALE = 16.0f, ASCALE = 16.0f, MSCALE = 8.0f;

struct Params {
    const float* in[31];
    float* out;
    unsigned char* ws;
    double inv_freq[32];
    int seq[16];
    int nseq, use_grid_sync;
};
typedef const CAS Params* PP;

DI int tid_() { int t = threadIdx.x; asm volatile("" : "+v"(t)); return t; }
DI unsigned pk2(float lo, float hi) { f32x2 v = {lo, hi}; return __builtin_bit_cast(unsigned, __builtin_convertvector(v, bf16v2)); }
DI bf16_t f2bf(float x) { return (bf16_t)(pk2(x, 0.f) & 0xffffu); }
DI float clampf8(float x) { return fminf(fmaxf(x, -448.0f), 448.0f); }
DI unsigned pk4f8(float a, float b, float c, float d) {
    int r = __builtin_amdgcn_cvt_pk_fp8_f32(clampf8(a), clampf8(b), 0, false); r = __builtin_amdgcn_cvt_pk_fp8_f32(clampf8(c), clampf8(d), r, true); return (unsigned)r; }
DI float bf2f(unsigned u) { return __builtin_bit_cast(float, u << 16); }
DI float sigmoidf_(float x) { return 1.0f / (1.0f + __expf(-x)); }
DI float frcp_(float x) { return __builtin_amdgcn_rcpf(x); }
DI float sigmoidq_(float x) { return frcp_(1.0f + __expf(-x)); }
DI float silu_(float x) { return x * frcp_(1.0f + __expf(-x)); }
DI float gelu_tanh_(float x) { const float z = 0.7978845608028654f * (x + 0.044715f * x * x * x); const float e = __expf(2.0f * z); const float th = 1.0f - 2.0f * frcp_(e + 1.0f); return 0.5f * x * (1.0f + th); }
DI int swap23(int p) { return (p & 3) | ((p & 4) << 1) | ((p & 8) >> 1); }
#define MFMA32(a, b, c) __builtin_amdgcn_mfma_f32_32x32x16_bf16((a), (b), (c), 0, 0, 0)

DI double exp_d(double x) {
    const double k = __builtin_rint(x * 1.4426950408889634);
    const double r = __builtin_fma(-k, 1.9082149292705877e-10, __builtin_fma(-k, 6.93147180369123816490e-01, x));
    double p = 1.0;
#pragma unroll 1
    for (int n = 16; n >= 1; --n) p = __builtin_fma(p * r, 1.0 / (double)n, 1.0);
    const long long ki = (long long)k;
    const double sc = __builtin_bit_cast(double, (unsigned long long)(ki + 1023) << 52);
    return p * sc;
}
DI void sincos_d(double x, double& s, double& c) {
    const double k = __builtin_rint(x * 0.63661977236758134308);
    double r = __builtin_fma(-k, 1.57079632673412561417e+00, x);
    r = __builtin_fma(-k, 6.07710050650619224932e-11, r);
    const double r2 = r * r;
    double ps = 1.0, pc = 1.0;
#pragma unroll 1
    for (int n = 9; n >= 1; --n) {
        ps = __builtin_fma(-ps * r2, 1.0 / (double)((2 * n) * (2 * n + 1)), 1.0);
        pc = __builtin_fma(-pc * r2, 1.0 / (double)((2 * n - 1) * (2 * n)), 1.0);
    }
    const double sr = r * ps, cr = pc;
    const int q = (int)((long long)k & 3);
    s = (q == 0) ? sr : (q == 1) ? cr : (q == 2) ? -sr : -cr;
    c = (q == 0) ? cr : (q == 1) ? -sr : (q == 2) ? -cr : sr;
}

constexpr int ROWB = 144;
template <int WM, int WN, int MT, int NT, class ARow, class BRow>
DI void gemm_mainloop(LAS unsigned char* lds, const ARow& arow, const BRow& brow, const int K, f32x16 (&acc)[MT][NT]) {
    constexpr int BM = WM * MT * 32, BN = WN * NT * 32;
    constexpr int NA = BM * 8, NBc = BN * 8;
    constexpr int ACH = (NA + NTHREADS - 1) / NTHREADS, BCH = (NBc + NTHREADS - 1) / NTHREADS;
    constexpr int A_BYTES = BM * ROWB, STAGE = (BM + BN) * ROWB;
    static_assert(2 * STAGE <= LDS_BYTES, "gemm stages fit LDS");
    const int tid = tid_(), lane = tid & 63, wid = tid >> 6;
    __builtin_assume(tid >= 0 && tid < NTHREADS);
    const int wm = wid / WN, wn = wid % WN;
    const bf16_t* ap[ACH]; const bf16_t* bp[BCH];
    int aw[ACH], bw[BCH];
#pragma unroll
    for (int i = 0; i < ACH; ++i) { const int c = tid + NTHREADS * i; const bool v = c < NA; const int r = v ? (c >> 3) : 0; ap[i] = arow(r) + (c & 7) * 8; aw[i] = r * ROWB + (c & 7) * 16; }
#pragma unroll
    for (int i = 0; i < BCH; ++i) { const int c = tid + NTHREADS * i; const bool v = c < NBc; const int r = v ? (c >> 3) : 0; bp[i] = brow(r) + (c & 7) * 8; bw[i] = A_BYTES + r * ROWB + (c & 7) * 16; }
    const int aoff = (wm * MT * 32 + (lane & 31)) * ROWB + (lane >> 5) * 16;
    const int boff = A_BYTES + (wn * NT * 32 + (lane & 31)) * ROWB + (lane >> 5) * 16;
    u32x4 ra0[ACH], rb0[BCH], ra1[ACH], rb1[BCH];
    const int nk = K >> 6;
#define GM_LOAD(ra, rb, kt) do { _Pragma("unroll") for (int i = 0; i < ACH; ++i) ra[i] = *(const u32x4*)(ap[i] + (kt) * 64); \
        _Pragma("unroll") for (int i = 0; i < BCH; ++i) rb[i] = *(const u32x4*)(bp[i] + (kt) * 64); } while (0)
#define GM_STORE(ra, rb, off) do { _Pragma("unroll") for (int i = 0; i < ACH; ++i) if (tid + NTHREADS * i < NA) *(LAS u32x4*)(lds + (off) + aw[i]) = ra[i]; \
        _Pragma("unroll") for (int i = 0; i < BCH; ++i) if (tid + NTHREADS * i < NBc) *(LAS u32x4*)(lds + (off) + bw[i]) = rb[i]; } while (0)
#define GM_COMPUTE(cur) do { _Pragma("unroll") for (int ks = 0; ks < 4; ++ks) { bf16x8 af[MT], wf[NT]; \
        _Pragma("unroll") for (int mt = 0; mt < MT; ++mt) af[mt] = *(const LAS bf16x8*)(lds + (cur) + aoff + mt * 32 * ROWB + ks * 32); \
        _Pragma("unroll") for (int nt = 0; nt < NT; ++nt) wf[nt] = *(const LAS bf16x8*)(lds + (cur) + boff + nt * 32 * ROWB + ks * 32); \
        _Pragma("unroll") for (int mt = 0; mt < MT; ++mt) _Pragma("unroll") for (int nt = 0; nt < NT; ++nt) acc[mt][nt] = MFMA32(wf[nt], af[mt], acc[mt][nt]); } } while (0)
    GM_LOAD(ra0, rb0, 0);
    if (nk > 1) GM_LOAD(ra1, rb1, 1);
    GM_STORE(ra0, rb0, 0);
    __syncthreads();
#define GM_SYNC() do { asm volatile("s_waitcnt lgkmcnt(0)" ::: "memory"); __syncthreads(); } while (0)
    for (int kt = 0; kt < nk; kt += 2) {
        if (kt + 2 < nk) GM_LOAD(ra0, rb0, kt + 2);
        GM_COMPUTE(0);
        if (kt + 1 < nk) GM_STORE(ra1, rb1, STAGE);
        GM_SYNC();
        if (kt + 3 < nk) GM_LOAD(ra1, rb1, kt + 3);
        if (kt + 1 < nk) GM_COMPUTE(STAGE);
        if (kt + 2 < nk) GM_STORE(ra0, rb0, 0);
        GM_SYNC();
    }
#undef GM_SYNC
#undef GM_LOAD
#undef GM_STORE
#undef GM_COMPUTE
}
template <int MT, int NT> DI void zero_acc(f32x16 (&acc)[MT][NT]) {
#pragma unroll
    for (int a = 0; a < MT; ++a)
#pragma unroll
        for (int b = 0; b < NT; ++b)
#pragma unroll
            for (int r = 0; r < 16; ++r) acc[a][b][r] = 0.f;
}
struct RowLin { const bf16_t* base; size_t ld; DI const bf16_t* operator()(int r) const { return base + (size_t)r * ld; } };
struct RowGather { const bf16_t* base; size_t ld; const int* idx; int nvalid; DI const bf16_t* operator()(int r) const { const int rr = r < nvalid ? r : 0; return base + (size_t)idx[rr] * ld; } };


constexpr int PG_HTB = 128 * 64 * 2, PG_STAGE_BYTES = 8 * PG_HTB;
static_assert(PG_STAGE_BYTES + 2048 <= LDS_BYTES, "stage region + tables fit LDS");
DI int pg_lds_byte(int r, int c) { const int st = (r >> 4) * 2 + (c >> 5), rr = r & 15, cc = c & 31, ob = rr * 64 + cc * 2; return st * 1024 + (ob ^ (((ob >> 9) & 1) << 5)); }
DI void pg_stage_rc(int b, int& R, int& C) { const int st = b / 1024, sb = b % 1024, swz = sb ^ (((sb >> 9) & 1) << 5); R = (st >> 1) * 16 + swz / 64; C = (st & 1) * 32 + (swz % 64) / 2; }
DI int pg_perm32(int rho) { const int n = rho >> 4, i = rho & 15; return 8 * (i >> 2) + 4 * n + (i & 3); }
DI const char* sgpr_ptr(const char* p) { const unsigned lo = __builtin_amdgcn_readfirstlane((unsigned)(size_t)p), hi = __builtin_amdgcn_readfirstlane((unsigned)((size_t)p >> 32)); return (const char*)(((size_t)hi << 32) | (size_t)lo); }
struct PgUnit { const char* a; const char* b; const int* gidx; int nvalid; int i0, i1, i2, i3; };
typedef f32x4 PgAcc[2][2][4][2];
typedef int i32x8 __attribute__((ext_vector_type(8)));
template <bool PERM, bool F8, bool XH, class Sched, class Epi>
DI void pg_gemm_phase(LAS unsigned char* lds, const int KB, const Sched& S, const Epi& E) {
    const int tid = tid_(), wid = __builtin_amdgcn_readfirstlane(tid >> 6), lane = tid & 63, wr = wid >> 2, wc = wid & 3, fr = lane & 15, fq = lane >> 4;
    const int nt = KB / 128;
    int Rl[2], Cl[2]; unsigned voffB[2];
#pragma unroll
    for (int i = 0; i < 2; ++i) { pg_stage_rc(tid * 16 + i * 8192, Rl[i], Cl[i]); const int r31 = PERM ? pg_perm32(Rl[i] & 31) : (Rl[i] & 31); const int Rb = (XH ? (Rl[i] >> 5) * 64 : (Rl[i] & ~31)) + r31; voffB[i] = (unsigned)(Rb * KB + Cl[i] * 2); }
    const size_t kstep = 128, hstep = (size_t)(XH ? 32 : 128) * KB;
    const unsigned ldsw = (unsigned)wid * 1024u;
    const int aoff0 = pg_lds_byte(wr * 64 + fr, F8 ? 16 * fq : fq * 8), aoff1 = pg_lds_byte(wr * 64 + fr, F8 ? 16 * fq + 8 : fq * 8 + 32);
    const int boff0 = pg_lds_byte(wc * 32 + fr, F8 ? 16 * fq : fq * 8), boff1 = pg_lds_byte(wc * 32 + fr, F8 ? 16 * fq + 8 : fq * 8 + 32);
#define PG_SA(b, h) (((b) * 2 + (h)) * PG_HTB)
#define PG_SB(b, h) ((4 + (b) * 2 + (h)) * PG_HTB)
#define PG_STAGE(bufoff, gbase, v0, v1) do { \
        __builtin_amdgcn_global_load_lds((const unsigned*)((const char*)(gbase) + (v0)), (LAS unsigned*)(lds + (bufoff) + ldsw), 16, 0, 0); \
        __builtin_amdgcn_global_load_lds((const unsigned*)((const char*)(gbase) + (v1)), (LAS unsigned*)(lds + (bufoff) + ldsw + 8192), 16, 0, 0); } while (0)
#define PG_STAGE_B(bufoff, gbase) PG_STAGE(bufoff, gbase, voffB[0], voffB[1])
#define PG_LD8(dst, base0, base1) do { const u32x4 lo_ = *(const LAS u32x4*)(lds + (base0)), hi_ = *(const LAS u32x4*)(lds + (base1)); \
        dst = (i32x8){(int)lo_.x, (int)lo_.y, (int)lo_.z, (int)lo_.w, (int)hi_.x, (int)hi_.y, (int)hi_.z, (int)hi_.w}; } while (0)
#define PG_LDA(dst, b, h) do { _Pragma("unroll") for (int m = 0; m < 4; ++m) PG_LD8(dst[m], PG_SA(b, h) + aoff0 + m * 2048, PG_SA(b, h) + aoff1 + m * 2048); } while (0)
#define PG_LDB(dst, b, h) do { _Pragma("unroll") for (int n = 0; n < 2; ++n) PG_LD8(dst[n], PG_SB(b, h) + boff0 + n * 2048, PG_SB(b, h) + boff1 + n * 2048); } while (0)
#define PG_LO(v) __builtin_bit_cast(bf16x8, __builtin_shufflevector(v, v, 0, 1, 2, 3))
#define PG_HI(v) __builtin_bit_cast(bf16x8, __builtin_shufflevector(v, v, 4, 5, 6, 7))
#define PG_MMA(ai, bj, At, Bt) do { __builtin_amdgcn_s_setprio(1); _Pragma("unroll") for (int m = 0; m < 4; ++m) _Pragma("unroll") for (int n = 0; n < 2; ++n) { \
        if constexpr (F8) asm volatile("v_mfma_scale_f32_16x16x128_f8f6f4 %0, %1, %2, %0, %3, %3 op_sel_hi:[0,0,0]" : "+v"(acc[ai][bj][m][n]) : "v"(Bt[n]), "v"(At[m]), "v"(sc1_)); \
        else { acc[ai][bj][m][n] = __builtin_amdgcn_mfma_f32_16x16x32_bf16(PG_LO(Bt[n]), PG_LO(At[m]), acc[ai][bj][m][n], 0, 0, 0); \
               acc[ai][bj][m][n] = __builtin_amdgcn_mfma_f32_16x16x32_bf16(PG_HI(Bt[n]), PG_HI(At[m]), acc[ai][bj][m][n], 0, 0, 0); } } \
        __builtin_amdgcn_s_setprio(0); } while (0)
#define PG_WAIT_V(n) asm volatile("s_waitcnt vmcnt(" #n ")" ::: "memory")
#define PG_WAIT_L(n) asm volatile("s_waitcnt lgkmcnt(" #n ")" ::: "memory")
#define PG_BAR __builtin_amdgcn_s_barrier()
#define PG_SCHED __builtin_amdgcn_sched_barrier(0)
#define PG_AOFF(u, vo) do { int R_[2], C_[2]; { const int t_ = tid_(); pg_stage_rc(t_ * 16, R_[0], C_[0]); pg_stage_rc(t_ * 16 + 8192, R_[1], C_[1]); } \
        if ((u).gidx) { int g_[2][2]; \
            _Pragma("unroll") for (int hh = 0; hh < 2; ++hh) _Pragma("unroll") for (int i = 0; i < 2; ++i) { const int row = R_[i] + 128 * hh; g_[hh][i] = (u).gidx[row < (u).nvalid ? row : 0]; } \
            _Pragma("unroll") for (int hh = 0; hh < 2; ++hh) _Pragma("unroll") for (int i = 0; i < 2; ++i) vo[hh][i] = (unsigned)g_[hh][i] * (unsigned)KB + (unsigned)(C_[i] * 2); } \
        else { _Pragma("unroll") for (int hh = 0; hh < 2; ++hh) _Pragma("unroll") for (int i = 0; i < 2; ++i) vo[hh][i] = (unsigned)((R_[i] + 128 * hh) * KB + C_[i] * 2); } } while (0)
    PgUnit cur, nxt; int ui = 0;
    if (!S.next(0, cur)) return;
    PgAcc acc;
#pragma unroll
    for (int a = 0; a < 2; ++a)
#pragma unroll
        for (int b = 0; b < 2; ++b)
#pragma unroll
            for (int m = 0; m < 4; ++m)
#pragma unroll
                for (int n = 0; n < 2; ++n) { float z_ = 0.f; asm volatile("" : "+v"(z_)); acc[a][b][m][n] = (f32x4){z_, z_, z_, z_}; }
    i32x8 At[4], B0[2], B1[2];
    const int sc1_ = 0x7f7f7f7f;
    (void)sc1_;
    unsigned vo[2][2], w1s0, w1s1;
    PG_AOFF(cur, vo);
    const char* cA = sgpr_ptr(cur.a); const char* cB = sgpr_ptr(cur.b);
    PG_STAGE_B(PG_SB(0, 0), cB); PG_STAGE_B(PG_SB(0, 1), cB + hstep); PG_STAGE(PG_SA(0, 0), cA, vo[0][0], vo[0][1]); PG_STAGE(PG_SA(0, 1), cA, vo[1][0], vo[1][1]);
    if (wr == 1) PG_BAR;
    PG_WAIT_V(2); PG_BAR;
    PG_STAGE_B(PG_SB(1, 0), cB + kstep); PG_STAGE(PG_SA(1, 0), cA + kstep, vo[0][0], vo[0][1]); PG_STAGE_B(PG_SB(1, 1), cB + hstep + kstep);
    PG_WAIT_V(6); PG_BAR;
    for (;;) {
        const bool has_next = S.next(ui + 1, nxt);
        {
            unsigned nvo[2][2];
            if (has_next) { PG_AOFF(nxt, nvo); }
            else {
#pragma unroll
                for (int hh = 0; hh < 2; ++hh)
#pragma unroll
                    for (int i = 0; i < 2; ++i) nvo[hh][i] = vo[hh][i];
            }
            *(LAS u32x4*)(lds + PG_STAGE_BYTES + 2048 + tid_() * 16) = (u32x4){nvo[0][0], nvo[0][1], nvo[1][0], nvo[1][1]};
        }
        const char* nA = has_next ? sgpr_ptr(nxt.a) : cA; const char* nB = has_next ? sgpr_ptr(nxt.b) : cB;
#pragma unroll 1
        for (int t = 0; t < nt; t += 2) {
            const bool last = (t == nt - 2);
            const char* a1 = cA + (size_t)(t + 1) * kstep;
            const char* a2 = last ? nA : cA + (size_t)(t + 2) * kstep; const char* b2 = last ? nB : cB + (size_t)(t + 2) * kstep;
            const char* a3 = a2 + kstep; const char* b3 = b2 + kstep;
            if (last) { const u32x4 nv_ = *(const LAS u32x4*)(lds + PG_STAGE_BYTES + 2048 + tid_() * 16); vo[0][0] = nv_.x; vo[0][1] = nv_.y; w1s0 = vo[1][0]; w1s1 = vo[1][1]; vo[1][0] = nv_.z; vo[1][1] = nv_.w; } else { w1s0 = vo[1][0]; w1s1 = vo[1][1]; }
            const unsigned w00 = vo[0][0], w01 = vo[0][1], w10 = vo[1][0], w11 = vo[1][1];
            PG_LDB(B0, 0, 0); PG_LDB(B1, 0, 1); PG_SCHED; PG_LDA(At, 0, 0); PG_STAGE(PG_SA(1, 1), a1, w1s0, w1s1);
            PG_WAIT_V(8); PG_WAIT_L(0); PG_BAR; PG_MMA(0, 0, At, B0); PG_MMA(0, 1, At, B1); PG_BAR; PG_SCHED;
            PG_LDA(At, 0, 1); PG_STAGE_B(PG_SB(0, 0), b2); PG_STAGE_B(PG_SB(0, 1), b2 + hstep); PG_STAGE(PG_SA(0, 0), a2, w00, w01);
            PG_WAIT_V(8); PG_WAIT_L(0); PG_BAR; PG_MMA(1, 0, At, B0); PG_MMA(1, 1, At, B1); PG_BAR; PG_SCHED;
            PG_LDB(B0, 1, 0); PG_LDB(B1, 1, 1); PG_SCHED; PG_LDA(At, 1, 0); PG_STAGE(PG_SA(0, 1), a2, w10, w11);
            PG_WAIT_V(8); PG_WAIT_L(0); PG_BAR; PG_MMA(0, 0, At, B0); PG_MMA(0, 1, At, B1); PG_BAR; PG_SCHED;
            PG_LDA(At, 1, 1); PG_STAGE_B(PG_SB(1, 0), b3); PG_STAGE_B(PG_SB(1, 1), b3 + hstep); PG_STAGE(PG_SA(1, 0), a3, w00, w01);
            PG_WAIT_V(8); PG_WAIT_L(0); PG_BAR; PG_MMA(1, 0, At, B0); PG_MMA(1, 1, At, B1); PG_BAR; PG_SCHED;
        }
        if (wr == 0) PG_BAR;
        if constexpr (F8) asm volatile("s_nop 15\n\ts_nop 7" ::: "memory");
        E(acc, cur, wr, wc, fr, fq);
        if (!has_next) break;
#pragma unroll
        for (int a = 0; a < 2; ++a)
#pragma unroll
            for (int b = 0; b < 2; ++b)
#pragma unroll
                for (int m = 0; m < 4; ++m)
#pragma unroll
                    for (int n = 0; n < 2; ++n) { float z_ = 0.f; asm volatile("" : "+v"(z_)); acc[a][b][m][n] = (f32x4){z_, z_, z_, z_}; }
        if constexpr (F8) asm volatile("s_nop 7" ::: "memory");
        cur = nxt; cA = nA; cB = nB; ++ui;
        if (wr == 1) PG_BAR;
    }
    PG_WAIT_V(0);
    PG_BAR;
#undef PG_SA
#undef PG_SB
#undef PG_STAGE
#undef PG_STAGE_B
#undef PG_LDA
#undef PG_LDB
#undef PG_LD8
#undef PG_LO
#undef PG_HI
#undef PG_MMA
#undef PG_WAIT_V
#undef PG_WAIT_L
#undef PG_BAR
#undef PG_SCHED
#undef PG_AOFF
}
struct DenseOrder {
    const char* A; const char* B; int KB, nM, nN, nwg, G, c;
    DI bool next(int i, PgUnit& u) const {
        const long L = (long)i * G + c; if (L >= nwg) return false;
        int wgid = (int)L; { const int q = nwg / 8, r = nwg % 8, xcd = wgid % 8, off = wgid / 8; wgid = (xcd < r ? xcd * (q + 1) : r * (q + 1) + (xcd - r) * q) + off; }
        const int nig = 8 * nN, gid = wgid / nig, fm = gid * 8, gsz = (nM - fm) < 8 ? (nM - fm) : 8;
        const int pm = fm + ((wgid % nig) % gsz), pn = (wgid % nig) / gsz;
        u.a = A + (size_t)pm * 256 * KB; u.b = B + (size_t)pn * 256 * KB; u.gidx = nullptr; u.nvalid = 256; u.i0 = pm; u.i1 = pn; u.i2 = 0; u.i3 = 0; return true;
    }
};

template <int KPT, bool F8>
DI void conv_T(const float* src, int K, int N, int ld, void* dstv, const float* kscale, int rowmap, int slot, int nbatch, size_t src_bstride, size_t dst_bstride, long gtid, long gsize, LAS unsigned char* wl, int lane) {
    const long per = (long)(K / KPT) * N;
    const long total = per * nbatch;
    for (long c = gtid; c < total; c += gsize) {
        const int e = (int)(c / per); const long cc = c - (long)e * per;
        const int kb = (int)(cc / N), n = (int)(cc - (long)kb * N);
        const float* s = src + (size_t)e * src_bstride + (size_t)(kb * KPT) * ld + n;
        float v[KPT];
#pragma unroll
        for (int j = 0; j < KPT; ++j) v[j] = s[(size_t)j * ld];
        if (kscale) {
#pragma unroll
            for (int j = 0; j < KPT; ++j) v[j] *= kscale[kb * KPT + j];
        }
        u32x4 o[8];
        if constexpr (F8) {
#pragma unroll
            for (int j = 0; j < 8; ++j) {
                o[j].x = pk4f8(v[16 * j] * WSCALE, v[16 * j + 1] * WSCALE, v[16 * j + 2] * WSCALE, v[16 * j + 3] * WSCALE); o[j].y = pk4f8(v[16 * j + 4] * WSCALE, v[16 * j + 5] * WSCALE, v[16 * j + 6] * WSCALE, v[16 * j + 7] * WSCALE);
                o[j].z = pk4f8(v[16 * j + 8] * WSCALE, v[16 * j + 9] * WSCALE, v[16 * j + 10] * WSCALE, v[16 * j + 11] * WSCALE); o[j].w = pk4f8(v[16 * j + 12] * WSCALE, v[16 * j + 13] * WSCALE, v[16 * j + 14] * WSCALE, v[16 * j + 15] * WSCALE); }
        } else {
#pragma unroll
            for (int j = 0; j < 8; ++j) { o[j].x = pk2(v[8 * j], v[8 * j + 1]); o[j].y = pk2(v[8 * j + 2], v[8 * j + 3]); o[j].z = pk2(v[8 * j + 4], v[8 * j + 5]); o[j].w = pk2(v[8 * j + 6], v[8 * j + 7]); }
        }
#pragma unroll
        for (int j = 0; j < 8; ++j) *(LAS u32x4*)(wl + lane * 144 + 16 * j) = o[j];
        asm volatile("s_waitcnt lgkmcnt(0)" ::: "memory");
        unsigned char* dbase = (unsigned char*)dstv + ((size_t)e * dst_bstride + (size_t)kb * KPT) * (F8 ? 1 : 2) + 16 * (lane & 7);
#pragma unroll
        for (int i = 0; i < 8; ++i) {
            const int r = 8 * i + (lane >> 3), nn = n - lane + r;
            int row = nn;
            if (rowmap == 1) row = (nn >= 1856) ? nn + 192 : nn;
            else if (rowmap == 2) row = ((nn >> 4) << 5) + slot * 16 + (nn & 15);
            const u32x4 t = *(const LAS u32x4*)(wl + r * 144 + 16 * (lane & 7));
            *(u32x4*)(dbase + (size_t)row * K * (F8 ? 1 : 2)) = t;
        }
        asm volatile("s_waitcnt lgkmcnt(0)" ::: "memory");
    }
}

struct ConvDesc { int src, ks, K, N, rm, sl, nb, f8; unsigned long long dst, sb, db; int ld, n0; };
__device__ const ConvDesc conv_table[14] = {
    {3,  2,  D,    1856, 0, 0, 1,  0, OFF_WIN,   0, 0, 5952, 0},
    {3,  2,  D,    4096, 0, 0, 1,  1, OFF_WIN8,  0, 0, 5952, 1856},
    {5,  4,  QL,   1536, 0, 0, 1,  0, OFF_WQUP,  0, 0},
    {7,  6,  KVL,  2048, 0, 0, 1,  0, OFF_WKVUP, 0, 0},
    {18, -1, DSSM, D,    2, 0, 1,  1, OFF_WVG,   0, 0},
    {19, -1, DSSM, D,    2, 1, 1,  1, OFF_WVG,   0, 0},
    {20, -1, 1024, D,    0, 0, 1,  1, OFF_WMLA,  0, 0},
    {21, -1, D,    D,    0, 0, 1,  1, OFF_WOUT,  0, 0},
    {25, 22, D,    DE,   2, 0, NE, 1, OFF_WGU8,  (unsigned long long)D * DE, (unsigned long long)1024 * D},
    {26, 22, D,    DE,   2, 1, NE, 1, OFF_WGU8,  (unsigned long long)D * DE, (unsigned long long)1024 * D},
    {28, 22, D,    DE,   2, 0, 1,  1, OFF_WGU8 + (unsigned long long)NE * 1024 * D, 0, 0},
    {29, 22, D,    DE,   2, 1, 1,  1, OFF_WGU8 + (unsigned long long)NE * 1024 * D, 0, 0},
    {27, -1, DE,   D,    0, 0, NE, 1, OFF_WDN8,  (unsigned long long)DE * D, (unsigned long long)D * DE},
    {30, -1, DE,   D,    0, 0, 1,  1, OFF_WDN8 + (unsigned long long)NE * D * DE, 0, 0},
};
DI void phase0(PP p, LAS unsigned char* lds) {
    unsigned char* ws = p->ws;
    const long gtid = (long)blockIdx.x * NTHREADS + tid_(), gsize = (long)gridDim.x * NTHREADS;
    LAS unsigned char* wl = lds + ((int)(gtid & 511) >> 6) * 9216; const int lane0 = (int)(gtid & 63);
    if (gtid < 4096) ((int*)(ws + OFF_CNT))[gtid] = 0;
    for (int mi = 0; mi < 14; ++mi) {
        const ConvDesc cd = conv_table[mi];
        const int ld = cd.ld ? cd.ld : cd.N;
        if (cd.f8) conv_T<128, true>(p->in[cd.src] + cd.n0, cd.K, cd.N, ld, ws + cd.dst, cd.ks >= 0 ? p->in[cd.ks] : nullptr, cd.rm, cd.sl, cd.nb, cd.sb, cd.db, gtid, gsize, wl, lane0);
        else       conv_T<64, false>(p->in[cd.src] + cd.n0, cd.K, cd.N, ld, ws + cd.dst, cd.ks >= 0 ? p->in[cd.ks] : nullptr, cd.rm, cd.sl, cd.nb, cd.sb, cd.db, gtid, gsize, wl, lane0);
    }
    for (long c = gtid; c < (long)192 * D / 8; c += gsize) *(u32x4*)((bf16_t*)(ws + OFF_WIN) + (size_t)1856 * D + c * 8) = (u32x4){0u, 0u, 0u, 0u};
    { const float* wr = p->in[23]; const float* g2 = p->in[22]; float* o = (float*)(ws + OFF_WRT);
      for (long c = gtid; c < (long)D * NE; c += gsize) { const int j = (int)(c & 3), n = (int)(c >> 2) & 63, kk = (int)(c >> 8) & 3, S = (int)(c >> 10), k = 16 * S + 4 * kk + j; o[c] = wr[(size_t)k * NE + n] * g2[k]; } }
    { const int* pos = (const int*)p->in[1]; float* cs = (float*)(ws + OFF_CS);
      for (long c = gtid; c < (long)T * 32; c += gsize) { const int t = (int)(c >> 5), i = (int)(c & 31); double s, co; sincos_d((double)pos[t] * p->inv_freq[i], s, co); *(f32x2*)(cs + c * 2) = (f32x2){(float)co, (float)s}; } }
    { const float *a_re = p->in[10], *a_im = p->in[11], *log_dt = p->in[12], *b_re = p->in[13], *b_im = p->in[14], *c_re = p->in[15], *c_im = p->in[16];
      float* LB = (float*)(ws + OFF_LB); float* LBP = (float*)(ws + OFF_LBP); bf16_t* BB = (bf16_t*)(ws + OFF_BB); bf16_t* CM = (bf16_t*)(ws + OFF_CM);
      for (long c = gtid; c < (long)NG * NS; c += gsize) {
          const int g = (int)(c >> 6), n = (int)(c & 63);
          const double dt = exp_d((double)log_dt[g]);
          double lre = (double)a_re[c]; if (lre > -1e-4) lre = -1e-4;
          const double lim = (double)a_im[c];
          const double mag = exp_d(lre * dt); double sn, cn; sincos_d(lim * dt, sn, cn);
          const double lbr = mag * cn, lbi = mag * sn;
          const double den = lre * lre + lim * lim, nre = lbr - 1.0;
          const double cfr = (nre * lre + lbi * lim) / den, cfi = (lbi * lre - nre * lim) / den;
          LB[c * 2] = (float)lbr; LB[c * 2 + 1] = (float)lbi;
          double pr = lbr, pi = lbi;
#pragma unroll 1
          for (int i = 0; i < 8; ++i) { const double nr = pr * pr - pi * pi, ni = 2.0 * pr * pi; pr = nr; pi = ni; }
          LBP[c * 2] = (float)pr; LBP[c * 2 + 1] = (float)pi;
#pragma unroll
          for (int ch = 0; ch < GC; ++ch) {
              const double br = (double)b_re[c * GC + ch], bi = (double)b_im[c * GC + ch];
              BB[((size_t)g * 128 + n) * 16 + ch] = f2bf((float)(cfr * br - cfi * bi));
              BB[((size_t)g * 128 + 64 + n) * 16 + ch] = f2bf((float)(cfr * bi + cfi * br));
          }
      }
      for (long c = gtid; c < (long)NG * GC * NS; c += gsize) {
          const int gc_ = (int)(c >> 6), n = (int)(c & 63);
          CM[(size_t)gc_ * 128 + n] = f2bf(c_re[c]);
          CM[(size_t)gc_ * 128 + 64 + n] = f2bf(-c_im[c]);
      } }
    { const float* x = p->in[0]; bf16_t* xb = (bf16_t*)(ws + OFF_XB); float* rstd1 = (float*)(ws + OFF_RSTD1); unsigned* x8 = (unsigned*)(ws + OFF_X8);
      const int tid = tid_(); const int lane = tid & 63; const int gw = blockIdx.x * 8 + (tid >> 6), ngw = gridDim.x * 8;
      for (int row = gw; row < T; row += ngw) {
          const f32x4* xr = (const f32x4*)(x + (size_t)row * D) + lane;
          f32x4 v[8]; float s = 0.f;
#pragma unroll
          for (int j = 0; j < 8; ++j) { v[j] = xr[64 * j]; s += v[j].x * v[j].x + v[j].y * v[j].y + v[j].z * v[j].z + v[j].w * v[j].w; }
#pragma unroll
          for (int o = 1; o < 64; o <<= 1) s += __shfl_xor(s, o);
          if (lane == 0) rstd1[row] = 1.0f / sqrtf(s * (1.0f / D) + EPS);
          u32x2* o8 = (u32x2*)(xb + (size_t)row * D) + lane;
#pragma unroll
          for (int j = 0; j < 8; ++j) { o8[64 * j] = (u32x2){pk2(v[j].x, v[j].y), pk2(v[j].z, v[j].w)}; x8[(size_t)row * (D / 4) + 64 * j + lane] = pk4f8(v[j].x * XSCALE, v[j].y * XSCALE, v[j].z * XSCALE, v[j].w * XSCALE); }
      } }
}

struct EpiInProj {
    const float* rstd1; bf16_t* U; bf16_t* QLAT; bf16_t* KVLAT; bf16_t* SG; float* QSS; float* KSS; float* KPE;
    DI void operator()(const PgAcc& acc, const PgUnit& u, int wr, int wc, int fr, int fq) const {
        const int pm = u.i0, pn = u.i1;
        float rsv[8];
#pragma unroll
        for (int q = 0; q < 8; ++q) rsv[q] = rstd1[pm * 256 + (q >> 2) * 128 + wr * 64 + (q & 3) * 16 + fr];
#pragma unroll
        for (int ai = 0; ai < 2; ++ai)
#pragma unroll
            for (int m = 0; m < 4; ++m) {
                const int row = pm * 256 + ai * 128 + wr * 64 + m * 16 + fr;
                const float rs = rsv[ai * 4 + m];
#pragma unroll
                for (int bj = 0; bj < 2; ++bj) {
                    const int cl = bj * 128 + wc * 32 + 8 * fq;
                    const f32x4 v0 = acc[ai][bj][m][0] * rs, v1 = acc[ai][bj][m][1] * rs;
                    if (pn == 7) {
                        if (bj == 0 && wc < 2) { *(f32x4*)(KPE + (size_t)row * 64 + cl) = v0; *(f32x4*)(KPE + (size_t)row * 64 + cl + 4) = v1; }
                    } else {
                        const u32x4 o = {pk2(v0[0], v0[1]), pk2(v0[2], v0[3]), pk2(v1[0], v1[1]), pk2(v1[2], v1[3])};
                        if (pn < 4) *(u32x4*)(U + (size_t)row * 1024 + pn * 256 + cl) = o;
                        else {
                            float ssq = v0[0] * v0[0] + v0[1] * v0[1] + v0[2] * v0[2] + v0[3] * v0[3] + v1[0] * v1[0] + v1[1] * v1[1] + v1[2] * v1[2] + v1[3] * v1[3];
                            ssq += __shfl_xor(ssq, 16); ssq += __shfl_xor(ssq, 32);
                            if (pn < 6) { *(u32x4*)(QLAT + (size_t)row * 512 + (pn - 4) * 256 + cl) = o; if (fq == 0) QSS[(size_t)row * 16 + (pn - 4) * 8 + bj * 4 + wc] = ssq; }
                            else        { *(u32x4*)(KVLAT + (size_t)row * 256 + cl) = o; if (fq == 0) KSS[(size_t)row * 8 + bj * 4 + wc] = ssq; }
                        }
                    }
                }
            }
    }
};
struct EpiGate {
    const float* rstd1; bf16_t* SG;
    DI void operator()(const PgAcc& acc, const PgUnit& u, int wr, int wc, int fr, int fq) const {
        const int pm = u.i0, pn = u.i1;
        float rsv[8];
#pragma unroll
        for (int q = 0; q < 8; ++q) rsv[q] = rstd1[pm * 256 + (q >> 2) * 128 + wr * 64 + (q & 3) * 16 + fr] * (1.0f / (XSCALE * WSCALE));
#pragma unroll
        for (int ai = 0; ai < 2; ++ai)
#pragma unroll
            for (int m = 0; m < 4; ++m) {
                const int row = pm * 256 + ai * 128 + wr * 64 + m * 16 + fr;
                const float rs = rsv[ai * 4 + m];
#pragma unroll
                for (int bj = 0; bj < 2; ++bj) {
                    const int cl = bj * 128 + wc * 32 + 8 * fq;
                    const f32x4 v0 = acc[ai][bj][m][0] * rs, v1 = acc[ai][bj][m][1] * rs;
                    const u32x4 o = {pk2(sigmoidq_(v0[0]), sigmoidq_(v0[1])), pk2(sigmoidq_(v0[2]), sigmoidq_(v0[3])), pk2(sigmoidq_(v1[0]), sigmoidq_(v1[1])), pk2(sigmoidq_(v1[2]), sigmoidq_(v1[3]))};
                    *(u32x4*)(SG + (size_t)row * 4096 + pn * 256 + cl) = o;
                }
            }
    }
};
DI void phase1(PP p, LAS unsigned char* lds) {
    unsigned char* ws = p->ws;
    {
        const EpiInProj E{(const float*)(ws + OFF_RSTD1), (bf16_t*)(ws + OFF_U), (bf16_t*)(ws + OFF_QLAT), (bf16_t*)(ws + OFF_KVLAT), (bf16_t*)(ws + OFF_SG), (float*)(ws + OFF_QSS), (float*)(ws + OFF_KSS), (float*)(ws + OFF_KPE)};
        const DenseOrder S{(const char*)(ws + OFF_XB), (const char*)(ws + OFF_WIN), D * 2, T / 256, 8, (T / 256) * 8, (int)gridDim.x, (int)blockIdx.x};
        pg_gemm_phase<true, false, false>(lds, D * 2, S, E);
    }
    {
        const EpiGate E{(const float*)(ws + OFF_RSTD1), (bf16_t*)(ws + OFF_SG)};
        const DenseOrder S{(const char*)(ws + OFF_X8), (const char*)(ws + OFF_WIN8), D, T / 256, 16, (T / 256) * 16, (int)gridDim.x, (int)blockIdx.x};
        pg_gemm_phase<true, true, false>(lds, D, S, E);
    }
}

template <bool FULL>
DI void ssm_item(PP p, LAS unsigned char* wlds, int item, int lane) {
    unsigned char* ws = p->ws;
    asm volatile("" : "+v"(lane));
    const int g = (item / NSEG) % NG, b = item / (NSEG * NG);
    const int seg = (b == 0) ? item % NSEG : NSEG - 1 - item % NSEG;
    const int c = lane & 31, h = lane >> 5;
    const bf16_t* U = (const bf16_t*)(ws + OFF_U);
    const float* LB = (const float*)(ws + OFF_LB); const float* LBP = (const float*)(ws + OFF_LBP);
    const bf16_t* BB = (const bf16_t*)(ws + OFF_BB); const bf16_t* CM = (const bf16_t*)(ws + OFF_CM);
    float* EST = (float*)(ws + OFF_EST);
    const f32x2 l0 = *(const f32x2*)(LB + ((size_t)g * 64 + c) * 2), l1 = *(const f32x2*)(LB + ((size_t)g * 64 + c + 32) * 2);
    bf16x8 bfr[4];
#pragma unroll
    for (int jt = 0; jt < 4; ++jt) bfr[jt] = *(const bf16x8*)(BB + ((size_t)g * 128 + jt * 32 + c) * 16 + 8 * h);
    float s0r = 0.f, s0i = 0.f, s1r = 0.f, s1i = 0.f;
    const size_t ebase = ((size_t)(b * NG + g) * NSEG) * 64;
    bf16x8 cfr[4];
    if (FULL) {
        const f32x2 p0 = *(const f32x2*)(LBP + ((size_t)g * 64 + c) * 2), p1 = *(const f32x2*)(LBP + ((size_t)g * 64 + c + 32) * 2);
#pragma unroll 1
        for (int j0 = 0; j0 < seg; j0 += 8) {
            f32x2 e0[8], e1[8];
#pragma unroll
            for (int k = 0; k < 8; ++k) { const int jj = (j0 + k < NSEG) ? j0 + k : NSEG - 1; e0[k] = *(const f32x2*)(EST + (ebase + (size_t)jj * 64 + c) * 2); e1[k] = *(const f32x2*)(EST + (ebase + (size_t)jj * 64 + c + 32) * 2); }
#pragma unroll
            for (int k = 0; k < 8; ++k) if (j0 + k < seg) {
                const float a = p0.x * s0r - p0.y * s0i + e0[k].x, bb_ = p0.x * s0i + p0.y * s0r + e0[k].y; s0r = a; s0i = bb_;
                const float cc = p1.x * s1r - p1.y * s1i + e1[k].x, dd = p1.x * s1i + p1.y * s1r + e1[k].y; s1r = cc; s1i = dd;
            }
        }
#pragma unroll
        for (int ks = 0; ks < 4; ++ks) cfr[ks] = *(const bf16x8*)(CM + ((size_t)g * 16 + (lane & 15)) * 128 + ks * 32 + 8 * (lane >> 4));
    }
    const size_t m0 = (size_t)b * SEQ + (size_t)seg * SEGLEN;
#pragma unroll 1
    for (int sc = 0; sc < SEGLEN / 32; ++sc) {
        const bf16x8 ufr = *(const bf16x8*)(U + (m0 + sc * 32 + c) * 1024 + g * 16 + 8 * h);
        f32x16 a[4];
#pragma unroll
        for (int jt = 0; jt < 4; ++jt) {
#pragma unroll
            for (int r = 0; r < 16; ++r) a[jt][r] = 0.f;
            a[jt] = MFMA32(ufr, bfr[jt], a[jt]);
        }
#pragma unroll
        for (int q = 0; q < 4; ++q) {
#pragma unroll
            for (int o = 0; o < 2; ++o) {
                const bool own = (h == o);
#pragma unroll
                for (int j = 0; j < 4; ++j) {
                    const int r = 4 * q + j;
                    const float n0r = l0.x * s0r - l0.y * s0i + a[0][r], n0i = l0.x * s0i + l0.y * s0r + a[2][r];
                    const float n1r = l1.x * s1r - l1.y * s1i + a[1][r], n1i = l1.x * s1i + l1.y * s1r + a[3][r];
                    s0r = n0r; s0i = n0i; s1r = n1r; s1i = n1i;
                    if (FULL) { a[0][r] = own ? n0r : a[0][r]; a[2][r] = own ? n0i : a[2][r]; a[1][r] = own ? n1r : a[1][r]; a[3][r] = own ? n1i : a[3][r]; }
                }
                const float x0 = __shfl_xor(s0r, 32), x1 = __shfl_xor(s0i, 32), x2 = __shfl_xor(s1r, 32), x3 = __shfl_xor(s1i, 32);
                s0r = own ? s0r : x0; s0i = own ? s0i : x1; s1r = own ? s1r : x2; s1i = own ? s1i : x3;
            }
        }
        if (FULL) {
#pragma unroll
            for (int jt = 0; jt < 4; ++jt)
#pragma unroll
                for (int r = 0; r < 16; ++r) { const int t = (r & 3) + 8 * (r >> 2) + 4 * h; *(LAS bf16_t*)(wlds + (t * 136 + jt * 32 + c) * 2) = f2bf(a[jt][r]); }
            asm volatile("s_waitcnt lgkmcnt(0)" ::: "memory");
            const float* dvec = p->in[17]; unsigned char* YS = ws + OFF_YSSM;
            const int ch = lane & 15, tq = lane >> 4;
            const float dch = dvec[g * 16 + ch];
#pragma unroll
            for (int mt = 0; mt < 2; ++mt) {
                f32x4 y = {0.f, 0.f, 0.f, 0.f};
#pragma unroll
                for (int ks = 0; ks < 4; ++ks) {
                    const bf16x8 sf = *(const LAS bf16x8*)(wlds + ((mt * 16 + (lane & 15)) * 136 + ks * 32 + 8 * tq) * 2);
                    y = __builtin_amdgcn_mfma_f32_16x16x32_bf16(sf, cfr[ks], y, 0, 0, 0);
                }
#pragma unroll
                for (int i = 0; i < 4; ++i) {
                    const size_t m = m0 + sc * 32 + mt * 16 + 4 * tq + i;
                    const float uu = bf2f(U[m * 1024 + g * 16 + ch]);
                    YS[m * 1024 + g * 16 + ch] = (unsigned char)(pk4f8(gelu_tanh_(y[i] + dch * uu) * SSCALE, 0.f, 0.f, 0.f) & 0xffu);
                }
            }
            asm volatile("s_waitcnt lgkmcnt(0)" ::: "memory");
        }
    }
    if (!FULL && h == 0) {
        *(f32x2*)(EST + (ebase + (size_t)seg * 64 + c) * 2) = (f32x2){s0r, s0i};
        *(f32x2*)(EST + (ebase + (size_t)seg * 64 + c + 32) * 2) = (f32x2){s1r, s1i};
    }
}

constexpr float QSCALE = 0.07216878364870322f * 1.4426950408889634f;
constexpr int EROWB = 400;
DI void phase2(PP p, LAS unsigned char* lds) {
    unsigned char* ws = p->ws;
    const int tid = tid_(), lane = tid & 63, wid = tid >> 6, h = lane >> 5, lm = lane & 31;
    const float* CS = (const float*)(ws + OFF_CS);
    {
        const bf16_t* QLAT = (const bf16_t*)(ws + OFF_QLAT); const bf16_t* WQ = (const bf16_t*)(ws + OFF_WQUP);
        const float* QSS = (const float*)(ws + OFF_QSS); const float* qg = p->in[8];
        bf16_t* Q = (bf16_t*)(ws + OFF_Q);
        for (int u0 = blockIdx.x; u0 < (T / 256) * NH; u0 += gridDim.x) {
            int u = u0; if ((gridDim.x & 7) == 0 && ((T / 256) * NH) % (int)gridDim.x == 0) { const int x = u0 & 7, L = ((u0 / (int)gridDim.x) * ((int)gridDim.x >> 3)) + (((u0 % (int)gridDim.x)) >> 3); u = x * 64 + L; }
            const int pm = u >> 3, hd = u & 7;
            f32x16 acc[1][6]; zero_acc(acc);
            gemm_mainloop<8, 1, 1, 6>(lds, RowLin{QLAT + (size_t)pm * 256 * QL, (size_t)QL}, RowLin{WQ + (size_t)hd * QKD * QL, (size_t)QL}, QL, acc);
            const int m = pm * 256 + wid * 32 + lm;
            float sq = 0.f;
#pragma unroll
            for (int i = 0; i < 16; ++i) sq += QSS[(size_t)m * 16 + i];
            const float rq = 1.0f / sqrtf(sq * (1.0f / QL) + EPS);
            float ssq = 0.f;
#pragma unroll
            for (int nt = 0; nt < 6; ++nt)
#pragma unroll
                for (int r = 0; r < 16; ++r) { acc[0][nt][r] *= rq; ssq += acc[0][nt][r] * acc[0][nt][r]; }
            ssq += __shfl_xor(ssq, 32);
            const float rh = QSCALE / sqrtf(ssq * (1.0f / QKD) + EPS);
            LAS unsigned char* er = lds + wid * (32 * EROWB);
            LAS bf16_t* qrow = (LAS bf16_t*)(er + lm * EROWB);
            int ho = h; asm volatile("" : "+v"(ho));
            const float* qgo = qg + 4 * ho;
            asm volatile("" :: "v"(rh) : "memory");
#pragma unroll
            for (int nt = 0; nt < 4; ++nt) {
                if (nt == 2) asm volatile("" ::: "memory");
#pragma unroll
                for (int q = 0; q < 4; ++q) {
                    const int d = nt * 32 + 8 * q + 4 * h;
                    const f32x4 g4 = *(const f32x4*)(qgo + nt * 32 + 8 * q);
                    *(LAS u32x2*)(qrow + d) = (u32x2){pk2(acc[0][nt][4 * q] * rh * g4.x, acc[0][nt][4 * q + 1] * rh * g4.y), pk2(acc[0][nt][4 * q + 2] * rh * g4.z, acc[0][nt][4 * q + 3] * rh * g4.w)};
                }
            }
            asm volatile("" ::: "memory");
#pragma unroll
            for (int q = 0; q < 4; ++q) {
                const int i0 = 8 * q + 4 * h;
                const f32x4 ga = *(const f32x4*)(qgo + 128 + 8 * q), gb = *(const f32x4*)(qgo + 160 + 8 * q);
                const f32x4 csA = *(const f32x4*)(CS + ((size_t)m * 32 + i0) * 2), csB = *(const f32x4*)(CS + ((size_t)m * 32 + i0 + 2) * 2);
                const float x10 = acc[0][4][4 * q] * rh * ga.x, x11 = acc[0][4][4 * q + 1] * rh * ga.y, x12 = acc[0][4][4 * q + 2] * rh * ga.z, x13 = acc[0][4][4 * q + 3] * rh * ga.w;
                const float x20 = acc[0][5][4 * q] * rh * gb.x, x21 = acc[0][5][4 * q + 1] * rh * gb.y, x22 = acc[0][5][4 * q + 2] * rh * gb.z, x23 = acc[0][5][4 * q + 3] * rh * gb.w;
                *(LAS u32x2*)(qrow + 128 + i0) = (u32x2){pk2(x10 * csA.x - x20 * csA.y, x11 * csA.z - x21 * csA.w), pk2(x12 * csB.x - x22 * csB.y, x13 * csB.z - x23 * csB.w)};
                *(LAS u32x2*)(qrow + 160 + i0) = (u32x2){pk2(x20 * csA.x + x10 * csA.y, x21 * csA.z + x11 * csA.w), pk2(x22 * csB.x + x12 * csB.y, x23 * csB.z + x13 * csB.w)};
            }
            asm volatile("s_waitcnt lgkmcnt(0)" ::: "memory");
            { const int m0w = pm * 256 + wid * 32, b = m0w / SEQ, s0 = m0w % SEQ;
              unsigned char* gdst = (unsigned char*)(Q + ((size_t)(b * NH + hd) * SEQ + s0) * QKD);
#pragma unroll
              for (int k = 0; k < 12; ++k) { const int off = (k * 64 + lane) * 16, row = off / 384, col = off - row * 384; *(u32x4*)(gdst + off) = *(const LAS u32x4*)(er + row * EROWB + col); } }
            asm volatile("s_waitcnt lgkmcnt(0)" ::: "memory"); __syncthreads();
        }
    }
    {
        const bf16_t* KVLAT = (const bf16_t*)(ws + OFF_KVLAT); const bf16_t* WKV = (const bf16_t*)(ws + OFF_WKVUP);
        const float* KSS = (const float*)(ws + OFF_KSS); const float* KPE = (const float*)(ws + OFF_KPE); const float* kg = p->in[9];
        bf16_t* Kb = (bf16_t*)(ws + OFF_K); bf16_t* VT = (bf16_t*)(ws + OFF_VT);
        for (int u0 = blockIdx.x; u0 < (T / 256) * NH * 2; u0 += gridDim.x) {
            int u = u0; if ((gridDim.x & 7) == 0 && ((T / 256) * NH * 2) % (int)gridDim.x == 0) { const int x = u0 & 7, L = ((u0 / (int)gridDim.x) * ((int)gridDim.x >> 3)) + (((u0 % (int)gridDim.x)) >> 3); u = x * 128 + L; }
            const int part = u & 1, hd = (u >> 1) & 7, pm = u >> 4;
            f32x16 acc[1][4]; zero_acc(acc);
            gemm_mainloop<8, 1, 1, 4>(lds, RowLin{KVLAT + (size_t)pm * 256 * KVL, (size_t)KVL}, RowLin{WKV + ((size_t)hd * 256 + part * 128) * KVL, (size_t)KVL}, KVL, acc);
            const int m = pm * 256 + wid * 32 + lm;
            float skv = 0.f;
#pragma unroll
            for (int i = 0; i < 8; ++i) skv += KSS[(size_t)m * 8 + i];
            const float rkv = 1.0f / sqrtf(skv * (1.0f / KVL) + EPS);
            const int b = m / SEQ, s = m % SEQ;
            if (part == 0) {
                float ssq = 0.f;
#pragma unroll
                for (int nt = 0; nt < 4; ++nt)
#pragma unroll
                    for (int r = 0; r < 16; ++r) { acc[0][nt][r] *= rkv; ssq += acc[0][nt][r] * acc[0][nt][r]; }
                const float* kpr = KPE + (size_t)m * 64 + 16 * h;
#pragma unroll
                for (int j = 0; j < 4; ++j) { const f32x4 a4 = *(const f32x4*)(kpr + 4 * j), b4 = *(const f32x4*)(kpr + 32 + 4 * j);
                    ssq += a4.x * a4.x + a4.y * a4.y + a4.z * a4.z + a4.w * a4.w + b4.x * b4.x + b4.y * b4.y + b4.z * b4.z + b4.w * b4.w; }
                ssq += __shfl_xor(ssq, 32);
                const float rk = 1.0f / sqrtf(ssq * (1.0f / QKD) + EPS);
                LAS unsigned char* er = lds + wid * (32 * EROWB);
                LAS bf16_t* krow = (LAS bf16_t*)(er + lm * EROWB);
                int ho = h; asm volatile("" : "+v"(ho));
                asm volatile("" :: "v"(rk) : "memory");
#pragma unroll
                for (int nt = 0; nt < 4; ++nt) {
                    if (nt == 2) asm volatile("" ::: "memory");
#pragma unroll
                    for (int q = 0; q < 4; ++q) {
                        const int d = nt * 32 + 8 * q + 4 * h;
                        const f32x4 g4 = *(const f32x4*)(kg + 4 * ho + nt * 32 + 8 * q);
                        *(LAS u32x2*)(krow + d) = (u32x2){pk2(acc[0][nt][4 * q] * rk * g4.x, acc[0][nt][4 * q + 1] * rk * g4.y), pk2(acc[0][nt][4 * q + 2] * rk * g4.z, acc[0][nt][4 * q + 3] * rk * g4.w)};
                    }
                }
                asm volatile("" ::: "memory");
#pragma unroll
                for (int j = 0; j < 4; ++j) {
                    const int i0 = 16 * h + 4 * j;
                    const f32x4 ga = *(const f32x4*)(kg + 16 * ho + 128 + 4 * j), gb = *(const f32x4*)(kg + 16 * ho + 160 + 4 * j);
                    const f32x4 csA = *(const f32x4*)(CS + ((size_t)m * 32 + i0) * 2), csB = *(const f32x4*)(CS + ((size_t)m * 32 + i0 + 2) * 2);
                    const f32x4 pa4 = *(const f32x4*)(kpr + 4 * j), pb4 = *(const f32x4*)(kpr + 32 + 4 * j);
                    const float x10 = pa4.x * rk * ga.x, x11 = pa4.y * rk * ga.y, x12 = pa4.z * rk * ga.z, x13 = pa4.w * rk * ga.w;
                    const float x20 = pb4.x * rk * gb.x, x21 = pb4.y * rk * gb.y, x22 = pb4.z * rk * gb.z, x23 = pb4.w * rk * gb.w;
                    *(LAS u32x2*)(krow + 128 + i0) = (u32x2){pk2(x10 * csA.x - x20 * csA.y, x11 * csA.z - x21 * csA.w), pk2(x12 * csB.x - x22 * csB.y, x13 * csB.z - x23 * csB.w)};
                    *(LAS u32x2*)(krow + 160 + i0) = (u32x2){pk2(x20 * csA.x + x10 * csA.y, x21 * csA.z + x11 * csA.w), pk2(x22 * csB.x + x12 * csB.y, x23 * csB.z + x13 * csB.w)};
                }
                asm volatile("s_waitcnt lgkmcnt(0)" ::: "memory");
                { const int m0w = pm * 256 + wid * 32, s0 = m0w % SEQ;
                  unsigned char* gdst = (unsigned char*)(Kb + ((size_t)(b * NH + hd) * SEQ + s0) * QKD);
#pragma unroll
                  for (int k = 0; k < 12; ++k) { const int off = (k * 64 + lane) * 16, row = off / 384, col = off - row * 384; *(u32x4*)(gdst + off) = *(const LAS u32x4*)(er + row * EROWB + col); } }
            } else {
                LAS unsigned char* er = lds + wid * (32 * EROWB);
                const int pk_ = (lm & ~15) + swap23(lm & 15);
#pragma unroll
                for (int nt = 0; nt < 4; ++nt)
#pragma unroll
                    for (int r = 0; r < 16; ++r) { const int dv = nt * 32 + (r & 3) + 8 * (r >> 2) + 4 * h; *(LAS bf16_t*)(er + dv * 80 + pk_ * 2) = f2bf(acc[0][nt][r] * rkv); }
                asm volatile("s_waitcnt lgkmcnt(0)" ::: "memory");
                { const int s0 = (pm * 256 + wid * 32) % SEQ;
                  unsigned char* gdst = (unsigned char*)(VT + (size_t)(b * NH + hd) * VD * SEQ + s0);
#pragma unroll
                  for (int k = 0; k < 8; ++k) { const int idx = k * 64 + lane, dv = idx >> 2, sg = idx & 3; *(u32x4*)(gdst + (size_t)dv * SEQ * 2 + sg * 16) = *(const LAS u32x4*)(er + dv * 80 + sg * 16); } }
            }
            asm volatile("s_waitcnt lgkmcnt(0)" ::: "memory"); __syncthreads();
        }
    }
    for (int it = blockIdx.x * 8 + wid; it < NB * NG * NSEG; it += gridDim.x * 8) ssm_item<false>(p, lds + wid * 8704, it, lane);
}

constexpr int KROWB = 400, VROWB = 144, KT_BYTES = 64 * KROWB, ASTAGE = KT_BYTES + 128 * VROWB;
static_assert(2 * ASTAGE <= LDS_BYTES, "attention stages fit LDS");
#define ATT_QK4(S0, S1, kslot, k0) do { _Pragma("unroll") for (int ks = (k0); ks < (k0) + 4; ++ks) { \
            const bf16x8 kf0 = *(const LAS bf16x8*)(lds + (kslot) + koff + ks * 32), kf1 = *(const LAS bf16x8*)(lds + (kslot) + koff + 32 * KROWB + ks * 32); \
            S0 = MFMA32(kf0, qf[ks], S0); S1 = MFMA32(kf1, qf[ks], S1); } } while (0)
#define ATT_ZERO(S0, S1) do { _Pragma("unroll") for (int r = 0; r < 16; ++r) { S0[r] = 0.f; S1[r] = 0.f; } } while (0)
#define ATT_SM1(S0, S1) \
        float mx = S0[0]; \
        _Pragma("unroll") for (int r = 0; r < 16; ++r) { mx = fmaxf(mx, S0[r]); mx = fmaxf(mx, S1[r]); } \
        mx = fmaxf(mx, __shfl_xor(mx, 32)); \
        const float m_new = fmaxf(m_run, mx); const float alpha = __builtin_amdgcn_exp2f(m_run - m_new); m_run = m_new;
#define ATT_SM2(S0, S1) \
        float ls = 0.f; \
        _Pragma("unroll") for (int r = 0; r < 16; ++r) { const float e0 = __builtin_amdgcn_exp2f(S0[r] - m_new), e1 = __builtin_amdgcn_exp2f(S1[r] - m_new); S0[r] = e0; S1[r] = e1; ls += e0 + e1; } \
        l_run = l_run * alpha + ls;
#define ATT_SM3(S0, S1) \
        _Pragma("unroll") for (int d = 0; d < 4; ++d) _Pragma("unroll") for (int r = 0; r < 16; ++r) o[d][r] *= alpha; \
        bf16x8 pf[4]; \
        { u32x4 pk; pk.x = pk2(S0[0], S0[1]); pk.y = pk2(S0[2], S0[3]); pk.z = pk2(S0[4], S0[5]); pk.w = pk2(S0[6], S0[7]); pf[0] = __builtin_bit_cast(bf16x8, pk); \
          pk.x = pk2(S0[8], S0[9]); pk.y = pk2(S0[10], S0[11]); pk.z = pk2(S0[12], S0[13]); pk.w = pk2(S0[14], S0[15]); pf[1] = __builtin_bit_cast(bf16x8, pk); \
          pk.x = pk2(S1[0], S1[1]); pk.y = pk2(S1[2], S1[3]); pk.z = pk2(S1[4], S1[5]); pk.w = pk2(S1[6], S1[7]); pf[2] = __builtin_bit_cast(bf16x8, pk); \
          pk.x = pk2(S1[8], S1[9]); pk.y = pk2(S1[10], S1[11]); pk.z = pk2(S1[12], S1[13]); pk.w = pk2(S1[14], S1[15]); pf[3] = __builtin_bit_cast(bf16x8, pk); }
#define ATT_PV2(vslot, d0) do { _Pragma("unroll") for (int d = (d0); d < (d0) + 2; ++d) _Pragma("unroll") for (int kk = 0; kk < 4; ++kk) { \
            const bf16x8 vf = *(const LAS bf16x8*)(lds + (vslot) + voff + d * 32 * VROWB + kk * 32); o[d] = MFMA32(vf, pf[kk], o[d]); } } while (0)
#define ATT_SB __builtin_amdgcn_sched_barrier(0)
#define ATT_TILE(S0, S1, T0, T1, kslot, vslot, MASKED) do { \
        if (MASKED) { _Pragma("unroll") for (int r = 0; r < 16; ++r) { S0[r] = -INFINITY; S1[r] = -INFINITY; } } \
        ATT_ZERO(T0, T1); ATT_QK4(T0, T1, kslot, 0); \
        ATT_SM1(S0, S1) ATT_SB; \
        ATT_QK4(T0, T1, kslot, 4); \
        ATT_SM2(S0, S1) ATT_SB; \
        ATT_QK4(T0, T1, kslot, 8); \
        ATT_SM3(S0, S1) ATT_SB; \
        ATT_PV2(vslot, 0); ATT_SB; ATT_PV2(vslot, 2); } while (0)
DI void attn_unit(PP p, LAS unsigned char* lds, int b, int hd, int qb) {
    unsigned char* ws = p->ws;
    const int tid = tid_(), lane = tid & 63, wid = __builtin_amdgcn_readfirstlane(tid >> 6), h = lane >> 5, lm = lane & 31;
    const bf16_t* Qb = (const bf16_t*)(ws + OFF_Q) + (size_t)(b * NH + hd) * SEQ * QKD;
    const char* Kb = (const char*)((const bf16_t*)(ws + OFF_K) + (size_t)(b * NH + hd) * SEQ * QKD);
    const char* Vb = (const char*)((const bf16_t*)(ws + OFF_VT) + (size_t)(b * NH + hd) * VD * SEQ);
    const int sq = qb * 256 + wid * 32 + lm;
    bf16x8 qf[12];
#pragma unroll
    for (int ks = 0; ks < 12; ++ks) qf[ks] = *(const bf16x8*)(Qb + (size_t)sq * QKD + ks * 16 + 8 * h);
    const int ntiles = 4 * qb + 4, my_last = 4 * qb + (wid >> 1);
    unsigned ksrc[4], vsrc[3];
#pragma unroll
    for (int i = 0; i < 4; ++i) { const int byte = 1024 * (wid + 8 * i) + 16 * lane, row = byte / KROWB, cb = byte % KROWB; ksrc[i] = (unsigned)(row * (QKD * 2) + (cb < QKD * 2 ? cb : 0)); }
#pragma unroll
    for (int i = 0; i < 3; ++i) { const int byte = 1024 * (wid + 8 * i) + 16 * lane, row = byte / VROWB, cb = byte % VROWB; vsrc[i] = (unsigned)(row * (SEQ * 2) + (cb < 128 ? cb : 0)); }
#define ATT_DMAK(j, slot) do { const char* kb_ = Kb + (size_t)(j) * 64 * QKD * 2; _Pragma("unroll") for (int i = 0; i < 4; ++i) if (wid + 8 * i < 25) \
        __builtin_amdgcn_global_load_lds((const unsigned*)(kb_ + ksrc[i]), (LAS unsigned*)(lds + (slot) * ASTAGE + 1024 * (wid + 8 * i)), 16, 0, 0); } while (0)
#define ATT_DMAV(j, slot) do { const char* vb_ = Vb + (size_t)(j) * 128; _Pragma("unroll") for (int i = 0; i < 3; ++i) if (wid + 8 * i < 18) \
        __builtin_amdgcn_global_load_lds((const unsigned*)(vb_ + vsrc[i]), (LAS unsigned*)(lds + (slot) * ASTAGE + KT_BYTES + 1024 * (wid + 8 * i)), 16, 0, 0); } while (0)
    f32x16 o[4];
#pragma unroll
    for (int d = 0; d < 4; ++d)
#pragma unroll
        for (int r = 0; r < 16; ++r) o[d][r] = 0.f;
    float m_run = -INFINITY, l_run = 0.f;
    const int koff = lm * KROWB + h * 16, voff = KT_BYTES + lm * VROWB + h * 16;
    f32x16 sA0, sA1, sB0, sB1;
    ATT_DMAK(0, 0); ATT_DMAK(1, 1); ATT_DMAV(0, 0);
    __syncthreads();
    ATT_ZERO(sA0, sA1); ATT_QK4(sA0, sA1, 0, 0); ATT_QK4(sA0, sA1, 0, 4); ATT_QK4(sA0, sA1, 0, 8);
    asm volatile("s_waitcnt lgkmcnt(0)" ::: "memory");
    __syncthreads();
#pragma unroll 1
    for (int j = 0; j < ntiles; j += 2) {
        if (j + 2 < ntiles) ATT_DMAK(j + 2, 0);
        ATT_DMAV(j + 1, 1);
        ATT_TILE(sA0, sA1, sB0, sB1, ASTAGE, 0, j > my_last);
        asm volatile("s_waitcnt lgkmcnt(0)" ::: "memory");
        __syncthreads();
        if (j + 3 < ntiles) ATT_DMAK(j + 3, 1);
        if (j + 2 < ntiles) ATT_DMAV(j + 2, 0);
        ATT_TILE(sB0, sB1, sA0, sA1, 0, ASTAGE, j + 1 > my_last);
        asm volatile("s_waitcnt lgkmcnt(0)" ::: "memory");
        __syncthreads();
    }
#undef ATT_DMAK
#undef ATT_DMAV
    const float inv = 1.0f / (l_run + __shfl_xor(l_run, 32));
    LAS unsigned char* er = lds + wid * (32 * 144);
    const float invs = inv * ASCALE;
#pragma unroll
    for (int d = 0; d < 4; ++d)
#pragma unroll
        for (int q = 0; q < 4; ++q) *(LAS unsigned*)(er + lm * 144 + (d * 32 + 8 * q + 4 * h)) = pk4f8(o[d][4 * q] * invs, o[d][4 * q + 1] * invs, o[d][4 * q + 2] * invs, o[d][4 * q + 3] * invs);
    asm volatile("s_waitcnt lgkmcnt(0)" ::: "memory");
    {
        unsigned char* gdst = ws + OFF_ATT + ((size_t)b * SEQ + (sq - lm)) * 1024 + hd * VD;
#pragma unroll
        for (int k = 0; k < 4; ++k) { const int idx = k * 64 + lane, row = idx >> 3, c16 = idx & 7; *(u32x4*)(gdst + (size_t)row * 1024 + c16 * 16) = *(const LAS u32x4*)(er + row * 144 + c16 * 16); }
    }
    asm volatile("s_waitcnt lgkmcnt(0)" ::: "memory");
    __syncthreads();
}
template <bool ATT, bool SSM>
DI void phase3(PP p, LAS unsigned char* lds) {
    const int tid = tid_(); const int wid = tid >> 6, lane = tid & 63;
    if (ATT) for (int w = blockIdx.x; w < 256; w += gridDim.x) {
        const int bh = (w & 7) * 2 + ((w >> 3) & 1), pi = w >> 4;
#pragma unroll 1
        for (int uu = 0; uu < 2; ++uu) attn_unit(p, lds, bh >> 3, bh & 7, uu ? pi : 31 - pi);
    }
    if (SSM) {
        const int t2 = tid_(), wid2 = t2 >> 6, lane2 = t2 & 63;
        for (int it = blockIdx.x * 8 + wid2; it < NB * NG * NSEG; it += gridDim.x * 8) ssm_item<true>(p, lds + wid2 * 8704, it, lane2);
    }
}

struct EpiMla {
    const bf16_t* SG; bf16_t* TMP;
    DI void operator()(const PgAcc& acc, const PgUnit& u, int wr, int wc, int fr, int fq) const {
        const int pm = u.i0, pn = u.i1;
        u32x4 gb[8][2];
#pragma unroll
        for (int q = 0; q < 8 + 2; ++q) {
            if (q < 8) {
                const int row = pm * 256 + (q >> 2) * 128 + wr * 64 + (q & 3) * 16 + fr;
#pragma unroll
                for (int bj = 0; bj < 2; ++bj) gb[q][bj] = *(const u32x4*)(SG + (size_t)row * 4096 + 2048 + pn * 256 + bj * 128 + wc * 32 + 8 * fq);
            }
            if (q >= 2) {
                const int s = q - 2, ai = s >> 2, m = s & 3;
                const int row = pm * 256 + ai * 128 + wr * 64 + m * 16 + fr;
#pragma unroll
                for (int bj = 0; bj < 2; ++bj) {
                    const int col = pn * 256 + bj * 128 + wc * 32 + 8 * fq;
                    const u32x4 g = gb[s][bj];
                    const f32x4 v0 = acc[ai][bj][m][0] * (1.0f / (ASCALE * WSCALE)), v1 = acc[ai][bj][m][1] * (1.0f / (ASCALE * WSCALE));
                    const u32x4 o = {pk2(v0[0] * bf2f(g.x & 0xffffu), v0[1] * bf2f(g.x >> 16)), pk2(v0[2] * bf2f(g.y & 0xffffu), v0[3] * bf2f(g.y >> 16)),
                                     pk2(v1[0] * bf2f(g.z & 0xffffu), v1[1] * bf2f(g.z >> 16)), pk2(v1[2] * bf2f(g.w & 0xffffu), v1[3] * bf2f(g.w >> 16))};
                    *(u32x4*)(TMP + (size_t)row * D + col) = o;
                }
            }
        }
    }
};
DI void phase4(PP p, LAS unsigned char* lds) {
    unsigned char* ws = p->ws;
    const EpiMla E{(const bf16_t*)(ws + OFF_SG), (bf16_t*)(ws + OFF_TMP)};
    const DenseOrder S{(const char*)(ws + OFF_ATT), (const char*)(ws + OFF_WMLA), 1024, T / 256, D / 256, (T / 256) * (D / 256), (int)gridDim.x, (int)blockIdx.x};
    pg_gemm_phase<true, true, false>(lds, 1024, S, E);
}
struct EpiGlu {
    const bf16_t* SG; const bf16_t* TMP; bf16_t* MRG;
    DI void operator()(const PgAcc& acc, const PgUnit& u, int wr, int wc, int fr, int fq) const {
        const int pm = u.i0, pn = u.i1;
        u32x2 gb[8][2], tb[8][2];
#pragma unroll
        for (int q = 0; q < 8 + 2; ++q) {
            if (q < 8) {
                const int row = pm * 256 + (q >> 2) * 128 + wr * 64 + (q & 3) * 16 + fr;
#pragma unroll
                for (int bj = 0; bj < 2; ++bj) { const int col = pn * 128 + bj * 64 + wc * 16 + 4 * fq; gb[q][bj] = *(const u32x2*)(SG + (size_t)row * 4096 + col); tb[q][bj] = *(const u32x2*)(TMP + (size_t)row * D + col); }
            }
            if (q >= 2) {
                const int s = q - 2, ai = s >> 2, m = s & 3;
                const int row = pm * 256 + ai * 128 + wr * 64 + m * 16 + fr;
#pragma unroll
                for (int bj = 0; bj < 2; ++bj) {
                    const int col = pn * 128 + bj * 64 + wc * 16 + 4 * fq;
                    const u32x2 g = gb[s][bj], t = tb[s][bj];
                    const f32x4 v = acc[ai][bj][m][0] * (1.0f / (WSCALE * SSCALE)), gt = acc[ai][bj][m][1] * (1.0f / (WSCALE * SSCALE));
                    const float r0 = bf2f(t.x & 0xffffu) + bf2f(g.x & 0xffffu) * v[0] * sigmoidq_(gt[0]), r1 = bf2f(t.x >> 16) + bf2f(g.x >> 16) * v[1] * sigmoidq_(gt[1]);
                    const float r2 = bf2f(t.y & 0xffffu) + bf2f(g.y & 0xffffu) * v[2] * sigmoidq_(gt[2]), r3 = bf2f(t.y >> 16) + bf2f(g.y >> 16) * v[3] * sigmoidq_(gt[3]);
                    *(unsigned*)((unsigned char*)MRG + (size_t)row * D + col) = pk4f8(r0 * MSCALE, r1 * MSCALE, r2 * MSCALE, r3 * MSCALE);
                }
            }
        }
    }
};
DI void phase5(PP p, LAS unsigned char* lds) {
    unsigned char* ws = p->ws;
    const EpiGlu E{(const bf16_t*)(ws + OFF_SG), (const bf16_t*)(ws + OFF_TMP), (bf16_t*)(ws + OFF_MRG)};
    const DenseOrder S{(const char*)(ws + OFF_YSSM), (const char*)(ws + OFF_WVG), 1024, T / 256, 4096 / 256, (T / 256) * (4096 / 256), (int)gridDim.x, (int)blockIdx.x};
    pg_gemm_phase<false, true, false>(lds, 1024, S, E);
}
struct EpiOut {
    const float* x; float* out; unsigned char* X1F8; float* SSQ2;
    DI void operator()(const PgAcc& acc, const PgUnit& u, int wr, int wc, int fr, int fq) const {
        const int pm = u.i0, pn = u.i1;
        f32x4 xb[8][2][2];
#pragma unroll
        for (int q = 0; q < 8 + 2; ++q) {
            if (q < 8) {
                const int row = pm * 256 + (q >> 2) * 128 + wr * 64 + (q & 3) * 16 + fr;
#pragma unroll
                for (int bj = 0; bj < 2; ++bj)
#pragma unroll
                    for (int n = 0; n < 2; ++n) xb[q][bj][n] = *(const f32x4*)(x + (size_t)row * D + pn * 256 + bj * 128 + wc * 32 + n * 16 + 4 * fq);
            }
            if (q >= 2) {
                const int s = q - 2, ai = s >> 2, m = s & 3;
                const int row = pm * 256 + ai * 128 + wr * 64 + m * 16 + fr;
#pragma unroll
                for (int bj = 0; bj < 2; ++bj) {
                    float ssq = 0.f;
#pragma unroll
                    for (int n = 0; n < 2; ++n) {
                        const int col = pn * 256 + bj * 128 + wc * 32 + n * 16 + 4 * fq;
                        const f32x4 r = xb[s][bj][n] + acc[ai][bj][m][n] * (1.0f / (MSCALE * WSCALE));
                        ssq += r[0] * r[0] + r[1] * r[1] + r[2] * r[2] + r[3] * r[3];
                        *(f32x4*)(out + (size_t)row * D + col) = r;
                        *(unsigned*)(X1F8 + (size_t)row * D + col) = pk4f8(r[0], r[1], r[2], r[3]);
                    }
                    ssq += __shfl_xor(ssq, 16); ssq += __shfl_xor(ssq, 32);
                    if (fq == 0) SSQ2[(size_t)row * 64 + pn * 8 + bj * 4 + wc] = ssq;
                }
            }
        }
    }
};
DI void phase6(PP p, LAS unsigned char* lds) {
    unsigned char* ws = p->ws;
    const EpiOut E{p->in[0], p->out, ws + OFF_X1F8, (float*)(ws + OFF_SSQ2)};
    const DenseOrder S{(const char*)(ws + OFF_MRG), (const char*)(ws + OFF_WOUT), D, T / 256, D / 256, (T / 256) * (D / 256), (int)gridDim.x, (int)blockIdx.x};
    pg_gemm_phase<false, true, false>(lds, D, S, E);
}

template <bool TOPK>
DI void phase7(PP p, LAS unsigned char* lds) {
    unsigned char* ws = p->ws;
    const int tid = tid_(), lane = tid & 63, wid = tid >> 6, h = lane >> 5, lm = lane & 31;
    const float* x1 = p->out; const float* WRT = (const float*)(ws + OFF_WRT); const float* SSQ2 = (const float*)(ws + OFF_SSQ2);
    const float* bias = p->in[24];
    int* CNT = (int*)(ws + OFF_CNT); int* LIST = (int*)(ws + OFF_LIST); float* ROWW = (float*)(ws + OFF_ROWW); int* TPOS = (int*)(ws + OFF_TPOS);
    float* RSTD2 = (float*)(ws + OFF_RSTD2); float* RS2 = (float*)(ws + OFF_RS2);
    LAS float* part = (LAS float*)lds;
    LAS float* sc = (LAS float*)(lds + 65536);
    LAS float* rs = (LAS float*)(lds + 65536 + 8320);
    LAS float* selb = (LAS float*)(lds + 76800) + wid * 64;
    const float mybias = bias[lane];
    for (int u = blockIdx.x; u < T / 32; u += gridDim.x) {
        const int t0 = u * 32;
        f32x4 acc_[2][4];
#pragma unroll
        for (int mt = 0; mt < 2; ++mt)
#pragma unroll
            for (int nt = 0; nt < 4; ++nt) acc_[mt][nt] = (f32x4){0.f, 0.f, 0.f, 0.f};
        const int li = lane & 15, kk = lane >> 4;
        const float* xr = x1 + (size_t)(t0 + li) * D + wid * 256 + 4 * kk;
        const float* wq = WRT + ((size_t)(wid * 16) * 4 + kk) * 256 + li * 4;
        const int rotk = (wid * 3 + (int)blockIdx.x) & 15;
        f32x4 xa0[2], xa1[2], xa2[2], xa3[2], w0[4], w1[4], w2[4], w3[4];
#define RT_LD(xa, w, kb) do { const int kbr_ = ((kb) + rotk) & 15; xa[0] = *(const f32x4*)(xr + kbr_ * 16); xa[1] = *(const f32x4*)(xr + (size_t)16 * D + kbr_ * 16); \
            _Pragma("unroll") for (int nt = 0; nt < 4; ++nt) w[nt] = *(const f32x4*)(wq + (size_t)kbr_ * 1024 + nt * 64); } while (0)
#define RT_MM(xa, w) do { _Pragma("unroll") for (int j = 0; j < 4; ++j) _Pragma("unroll") for (int mt = 0; mt < 2; ++mt) _Pragma("unroll") for (int nt = 0; nt < 4; ++nt) \
            acc_[mt][nt] = __builtin_amdgcn_mfma_f32_16x16x4f32(xa[mt][j], w[nt][j], acc_[mt][nt], 0, 0, 0); } while (0)
        RT_LD(xa0, w0, 0); RT_LD(xa1, w1, 1); RT_LD(xa2, w2, 2);
#pragma unroll 1
        for (int kb = 0; kb < 16; kb += 4) {
            RT_LD(xa3, w3, kb + 3); RT_MM(xa0, w0);
            if (kb + 4 < 16) RT_LD(xa0, w0, kb + 4);
            RT_MM(xa1, w1);
            if (kb + 5 < 16) RT_LD(xa1, w1, kb + 5);
            RT_MM(xa2, w2);
            if (kb + 6 < 16) RT_LD(xa2, w2, kb + 6);
            RT_MM(xa3, w3);
        }
#undef RT_LD
#undef RT_MM
#pragma unroll
        for (int mt = 0; mt < 2; ++mt)
#pragma unroll
            for (int nt = 0; nt < 4; ++nt)
#pragma unroll
                for (int j = 0; j < 4; ++j) part[(wid * 32 + 16 * mt + 4 * kk + j) * 64 + 16 * nt + li] = acc_[mt][nt][j];
        if (tid < 32) { float s = 0.f;
#pragma unroll
            for (int i = 0; i < 64; ++i) s += SSQ2[(size_t)(t0 + tid) * 64 + i];
            const float r_ = 1.0f / sqrtf(s * (1.0f / D) + EPS); rs[tid] = r_; RSTD2[t0 + tid] = r_; }
        __syncthreads();
#pragma unroll
        for (int i = 0; i < 4; ++i) {
            const int idx = tid + NTHREADS * i, tok = idx >> 6, e = idx & 63;
            float s = 0.f;
#pragma unroll
            for (int w = 0; w < 8; ++w) s += part[(w * 32 + tok) * 64 + e];
            sc[tok * 65 + e] = sigmoidf_(s * rs[tok]);
        }
        asm volatile("s_waitcnt lgkmcnt(0)" ::: "memory");
        __syncthreads();
        LAS int* lcnt = (LAS int*)(lds + 78848);
        LAS int* rec = (LAS int*)(lds + 79872);
        if (tid < 64) lcnt[tid] = 0;
        __syncthreads();
#pragma unroll 1
        for (int i = 0; i < (TOPK ? 4 : 0); ++i) {
            const int tok = wid + 8 * i, e = lane, g = lane >> 3;
            const float score = sc[tok * 65 + e];
            const float sel = score + mybias;
            int rg = 0;
#pragma unroll
            for (int d = 1; d < 8; ++d) { const float o = __shfl_xor(sel, d); rg += (o > sel || (o == sel && (e ^ d) < e)) ? 1 : 0; }
            float gs = rg < 2 ? sel : 0.f;
            gs += __shfl_xor(gs, 1); gs += __shfl_xor(gs, 2); gs += __shfl_xor(gs, 4);
            int gr = 0;
#pragma unroll
            for (int d = 1; d < 8; ++d) { const float o = __shfl_xor(gs, 8 * d); gr += (o > gs || (o == gs && (g ^ d) < g)) ? 1 : 0; }
            const bool allowed = gr < 4;
            selb[e] = allowed ? sel : -INFINITY;
            asm volatile("s_waitcnt lgkmcnt(0)" ::: "memory");
            int rk = 0;
#pragma unroll 8
            for (int j = 0; j < 64; ++j) { const float o = selb[j]; rk += (o > sel || (o == sel && j < e)) ? 1 : 0; }
            const bool picked = allowed && rk < 8;
            float wsum = picked ? score : 0.f;
#pragma unroll
            for (int o = 1; o < 64; o <<= 1) wsum += __shfl_xor(wsum, o);
            if (picked) {
                const int ls = __hip_atomic_fetch_add(lcnt + e, 1, __ATOMIC_RELAXED, __HIP_MEMORY_SCOPE_WORKGROUP);
                LAS int* r_ = rec + (tok * 8 + rk) * 4;
                r_[0] = e; r_[1] = ls; r_[2] = __builtin_bit_cast(int, score * (2.5f / wsum));
            }
            asm volatile("s_waitcnt lgkmcnt(0)" ::: "memory");
        }
        __syncthreads();
        if (TOPK && tid < 64) lcnt[64 + tid] = atomicAdd(&CNT[tid * 64], lcnt[tid]);
        __syncthreads();
        if (TOPK && tid < 256) {
            const int tok = tid >> 3, t = t0 + tok;
            const LAS int* r_ = rec + tid * 4;
            const int e = r_[0], slot = lcnt[64 + e] + r_[1];
            LIST[(size_t)e * T + slot] = t; ROWW[(size_t)e * T + slot] = __builtin_bit_cast(float, r_[2]); RS2[(size_t)e * T + slot] = rs[tok]; TPOS[(size_t)t * 8 + (tid & 7)] = (e << 16) | slot;
        }
        asm volatile("s_waitcnt lgkmcnt(0)" ::: "memory");
        __syncthreads();
    }
}

DI void moe_tables(PP p, LAS int* tb) {
    const int* CNT = (const int*)(p->ws + OFF_CNT);
    const int tid = tid_();
    if (tid < NE) tb[256 + tid] = CNT[tid * 64];
    __syncthreads();
    if (tid == 0) { int tacc = 0, racc = 0;
        for (int e = 0; e < NE; ++e) { const int c = tb[256 + e]; tb[e] = tacc; tb[128 + e] = racc; tacc += (c + 255) >> 8; racc += c; }
        tb[NE] = tacc; tb[128 + NE] = T * TOPK; tb[NE + 1] = tacc + T / 256; tb[256 + NE] = T; }
    __syncthreads();
}
constexpr int MOE_MAXU = 64;
struct MoeOrder {
    LAS const int* tb; const int* list; const char* A; const char* B; size_t bstride; int KB, lognn, G, c; bool gather; LAS const int* ut;
    DI void locate(int i, int& e, int& mi, int& ni, int& nvalid, int& rbase) const {
        const int ntr = tb[NE + 1];
        int tr; e = -1;
        if ((G & 7) == 0) {
            const int x = c & 7, lo = (x * ntr) >> 3, hi = ((x + 1) * ntr) >> 3, Lx = i * (G >> 3) + (c >> 3);
            if (Lx >= ((hi - lo) << lognn)) return;
            tr = lo + (Lx >> lognn); ni = Lx & ((1 << lognn) - 1);
        } else {
            const int L = i * G + c; if (L >= (ntr << lognn)) return;
            tr = L >> lognn; ni = L & ((1 << lognn) - 1);
        }
        int ee = 0;
#pragma unroll 1
        for (int st_ = 64; st_ >= 1; st_ >>= 1) { const int c_ = ee + st_; if (c_ <= NE && tb[c_] <= tr) ee = c_; }
        e = ee; mi = tr - tb[ee]; nvalid = min(256, tb[256 + ee] - mi * 256); rbase = tb[128 + ee] + mi * 256;
    }
    DI void build(LAS int* utw) const {
        const int i = tid_();
        if (i < MOE_MAXU) { int e, mi = 0, ni = 0, nvalid = 0, rbase = 0; locate(i, e, mi, ni, nvalid, rbase);
            *(LAS u32x4*)(utw + i * 8) = (u32x4){(unsigned)e, (unsigned)mi, (unsigned)ni, (unsigned)nvalid}; utw[i * 8 + 4] = rbase; }
        asm volatile("s_waitcnt lgkmcnt(0)" ::: "memory");
        __syncthreads();
    }
    DI bool next(int i, PgUnit& u) const {
        int e, mi, ni, nvalid, rbase;
        if (i < MOE_MAXU) { const u32x4 d = *(const LAS u32x4*)(ut + i * 8); e = (int)d.x; mi = (int)d.y; ni = (int)d.z; nvalid = (int)d.w; rbase = ut[i * 8 + 4]; }
        else locate(i, e, mi, ni, nvalid, rbase);
        e = __builtin_amdgcn_readfirstlane(e);
        if (e < 0) return false;
        mi = __builtin_amdgcn_readfirstlane(mi); ni = __builtin_amdgcn_readfirstlane(ni); nvalid = __builtin_amdgcn_readfirstlane(nvalid); rbase = __builtin_amdgcn_readfirstlane(rbase);
        u.b = B + (size_t)e * bstride + (size_t)ni * 256 * KB;
        if (gather) { if (e < NE) { u.a = A; u.gidx = list + (size_t)e * T + mi * 256; } else { u.a = A + (size_t)mi * 256 * KB; u.gidx = nullptr; } }
        else { u.a = A + (size_t)rbase * KB; u.gidx = nullptr; }
        u.nvalid = nvalid; u.i0 = e; u.i1 = mi; u.i2 = ni; u.i3 = rbase; return true;
    }
};
struct EpiGateUp {
    const float* ROWW; const float* RS2; const float* RSTD2; unsigned char* HID8;
    DI void operator()(const PgAcc& acc, const PgUnit& u, int wr, int wc, int fr, int fq) const {
        const int e = u.i0, mi = u.i1, ni = u.i2, rbase = u.i3;
        const int cofs = ni * 128 + wc * 32 + ((fq & 1) ? 16 + 4 * (fq - 1) : 4 * fq);
        const float* r2p = (e < NE) ? RS2 + (size_t)e * T + mi * 256 : RSTD2 + mi * 256;
        const float* rwp = ROWW + (size_t)((e < NE) ? e : 0) * T + mi * 256;
        float r2v[8], rwv[8];
#pragma unroll
        for (int q = 0; q < 8; ++q) { const int rl = (q >> 2) * 128 + wr * 64 + (q & 3) * 16 + fr, rr = rl < u.nvalid ? rl : 0; r2v[q] = r2p[rr]; rwv[q] = rwp[rr]; }
        asm volatile("s_waitcnt vmcnt(0)" ::: "memory");
#pragma unroll
        for (int ai = 0; ai < 2; ++ai)
#pragma unroll
            for (int m = 0; m < 4; ++m) {
                const int rl = ai * 128 + wr * 64 + m * 16 + fr;
                const float r2 = r2v[ai * 4 + m] * (1.0f / WSCALE);
                const float rw = ((e < NE) ? rwv[ai * 4 + m] : 1.0f) * HSCALE;
                unsigned h[2];
#pragma unroll
                for (int bj = 0; bj < 2; ++bj) {
                    const f32x4 g = acc[ai][bj][m][0] * r2, up = acc[ai][bj][m][1] * (r2 * rw);
                    h[bj] = pk4f8(silu_(g[0]) * up[0], silu_(g[1]) * up[1], silu_(g[2]) * up[2], silu_(g[3]) * up[3]);
                }
                const auto s = __builtin_amdgcn_permlane16_swap(h[0], h[1], false, false);
                if (rl < u.nvalid) *(u32x2*)(HID8 + (size_t)(rbase + rl) * DE + cofs) = (u32x2){s[0], s[1]};
            }
    }
};
DI void phase8(PP p, LAS unsigned char* lds) {
    unsigned char* ws = p->ws;
    LAS int* tb = (LAS int*)(lds + PG_STAGE_BYTES);
    moe_tables(p, tb);
    const EpiGateUp E{(const float*)(ws + OFF_ROWW), (const float*)(ws + OFF_RS2), (const float*)(ws + OFF_RSTD2), ws + OFF_HID8};
    const MoeOrder S{tb, (const int*)(ws + OFF_LIST), (const char*)(ws + OFF_X1F8), (const char*)(ws + OFF_WGU8), (size_t)1024 * D, D, 2, (int)gridDim.x, (int)blockIdx.x, true, (LAS const int*)(lds + UT_OFF)};
    S.build((LAS int*)(lds + UT_OFF));
    pg_gemm_phase<false, true, true>(lds, D, S, E);
}
struct EpiDown {
    unsigned char* Y;
    DI void operator()(const PgAcc& acc, const PgUnit& u, int wr, int wc, int fr, int fq) const {
        const int ni = u.i2, rbase = u.i3;
        const int cofs = ni * 256 + wc * 64 + ((fq & 1) ? 32 + 8 * (fq - 1) : 8 * fq);
#pragma unroll
        for (int ai = 0; ai < 2; ++ai)
#pragma unroll
            for (int m = 0; m < 4; ++m) {
                const int rl = ai * 128 + wr * 64 + m * 16 + fr;
                const f32x4 a0 = acc[ai][0][m][0] * (YSCALE / (WSCALE * HSCALE)), a1 = acc[ai][0][m][1] * (YSCALE / (WSCALE * HSCALE));
                const f32x4 b0 = acc[ai][1][m][0] * (YSCALE / (WSCALE * HSCALE)), b1 = acc[ai][1][m][1] * (YSCALE / (WSCALE * HSCALE));
                const unsigned x0 = pk4f8(a0[0], a0[1], a0[2], a0[3]), x1 = pk4f8(a1[0], a1[1], a1[2], a1[3]);
                const unsigned z0 = pk4f8(b0[0], b0[1], b0[2], b0[3]), z1 = pk4f8(b1[0], b1[1], b1[2], b1[3]);
                const auto s0 = __builtin_amdgcn_permlane16_swap(x0, z0, false, false), s1 = __builtin_amdgcn_permlane16_swap(x1, z1, false, false);
                if (rl < u.nvalid) *(u32x4*)(Y + (size_t)(rbase + rl) * D + cofs) = (u32x4){s0[0], s1[0], s0[1], s1[1]};
            }
    }
};
DI void phase9(PP p, LAS unsigned char* lds) {
    unsigned char* ws = p->ws;
    LAS int* tb = (LAS int*)(lds + PG_STAGE_BYTES);
    moe_tables(p, tb);
    const EpiDown E{ws + OFF_Y};
    const MoeOrder S{tb, nullptr, (const char*)(ws + OFF_HID8), (const char*)(ws + OFF_WDN8), (size_t)D * DE, DE, 3, (int)gridDim.x, (int)blockIdx.x, false, (LAS const int*)(lds + UT_OFF)};
    S.build((LAS int*)(lds + UT_OFF));
    pg_gemm_phase<true, true, true>(lds, DE, S, E);
}
DI void phase10(PP p, LAS unsigned char* lds) {
    unsigned char* ws = p->ws;
    LAS int* tb = (LAS int*)(lds + PG_STAGE_BYTES);
    moe_tables(p, tb);
    const int tid = tid_(); const int lane = tid & 63, wid = tid >> 6;
    const int* TPOS = (const int*)(ws + OFF_TPOS); const unsigned char* Y = ws + OFF_Y; float* out = p->out;
    int t = blockIdx.x * 8 + wid;
    int tp[8];
    if (t < T) {
#pragma unroll
        for (int k = 0; k < 8; ++k) tp[k] = TPOS[(size_t)t * 8 + k];
    }
    for (; t < T; t += gridDim.x * 8) {
        const unsigned char* rp[9];
#pragma unroll
        for (int k = 0; k < 8; ++k) rp[k] = Y + ((size_t)tb[128 + (tp[k] >> 16)] + (size_t)(tp[k] & 0xffff)) * D + lane * 4;
        rp[8] = Y + ((size_t)T * TOPK + t) * D + lane * 4;
        const int tn = t + gridDim.x * 8;
        if (tn < T) {
#pragma unroll
            for (int k = 0; k < 8; ++k) tp[k] = TPOS[(size_t)tn * 8 + k];
        }
        unsigned v[8][9]; f32x4 o[8];
        f32x4* op = (f32x4*)(out + (size_t)t * D) + lane;
#pragma unroll
        for (int c = 0; c < 8; ++c) {
#pragma unroll
            for (int k = 0; k < 9; ++k) v[c][k] = *(const unsigned*)(rp[k] + c * 256);
            o[c] = op[c * 64];
        }
#pragma unroll
        for (int c = 0; c < 8; ++c) {
            float a0 = 0.f, a1 = 0.f, a2 = 0.f, a3 = 0.f;
#pragma unroll
            for (int k = 0; k < 9; ++k) { const int x_ = (int)v[c][k];
                const f32x2 lo = __builtin_amdgcn_cvt_pk_f32_fp8(x_, false), hi = __builtin_amdgcn_cvt_pk_f32_fp8(x_, true);
                a0 += lo[0]; a1 += lo[1]; a2 += hi[0]; a3 += hi[1]; }
            f32x4 r = o[c];
            r.x += a0 * (1.0f / YSCALE); r.y += a1 * (1.0f / YSCALE); r.z += a2 * (1.0f / YSCALE); r.w += a3 * (1.0f / YSCALE);
            op[c * 64] = r;
        }
    }
}

DI unsigned xb_ld(unsigned* p)              { return __hip_atomic_load(p, __ATOMIC_RELAXED, __HIP_MEMORY_SCOPE_AGENT); }
DI unsigned xb_add(unsigned* p, unsigned v) { return __hip_atomic_fetch_add(p, v, __ATOMIC_RELAXED, __HIP_MEMORY_SCOPE_AGENT); }
template <bool USE_CG>
DI void flat_barrier(unsigned* bar, unsigned& epoch, cg::grid_group& grid) {
    asm volatile("s_waitcnt vmcnt(0)" ::: "memory");
    __syncthreads();
    if (USE_CG) grid.sync();
    else {
        epoch += 1u;
        if (threadIdx.x == 0) {
            __builtin_amdgcn_fence(__ATOMIC_RELEASE, "agent");
            asm volatile("s_waitcnt vmcnt(0)" ::: "memory");
            (void)xb_add(bar, 1u);
            const unsigned want = epoch * gridDim.x;
            unsigned sp = 0u;
            while (xb_ld(bar) < want) { __builtin_amdgcn_s_sleep(1); if (++sp > (1u << 24)) break; }
            __builtin_amdgcn_fence(__ATOMIC_ACQUIRE, "agent");
            asm volatile("s_waitcnt vmcnt(0)" ::: "memory");
        }
        __syncthreads();
    }
}
#ifndef ONLY_PHASE
#define PH_ON(n) true
#else
#define PH_ON(n) ((n) == ONLY_PHASE)
#endif
extern __shared__ __attribute__((aligned(16))) unsigned char smem_raw[];
__global__ void __launch_bounds__(NTHREADS, 2) hybrid_fwd(Params p_unused) {
    LAS unsigned char* lds = (LAS unsigned char*)smem_raw;
    cg::grid_group grid = cg::this_grid();
    PP p = (PP)__builtin_amdgcn_kernarg_segment_ptr();
    unsigned epoch = 0u; bool first_seam = true;
    if (blockIdx.x == 0 && threadIdx.x == 0) __hip_atomic_store((unsigned*)(p->ws + OFF_BAR), 0u, __ATOMIC_RELAXED, __HIP_MEMORY_SCOPE_AGENT);
#define RUN_PHASE(n, call) do { asm volatile("" : "+s"(p)); asm volatile("" : "+s"(lds)); if (PH_ON(n)) { call; } } while (0)
#define SEAM() do { if (first_seam) { flat_barrier<true>((unsigned*)(p->ws + OFF_BAR), epoch, grid); first_seam = false; } else flat_barrier<false>((unsigned*)(p->ws + OFF_BAR), epoch, grid); } while (0)
    RUN_PHASE(0, phase0(p, lds));            SEAM();
#ifdef DUP_0
    RUN_PHASE(0, phase0(p, lds));            SEAM();
#endif
    RUN_PHASE(1, phase1(p, lds));       SEAM();
#ifdef DUP_1
    RUN_PHASE(1, phase1(p, lds));       SEAM();
#endif
    RUN_PHASE(2, phase2(p, lds));       SEAM();
#ifdef DUP_2
    RUN_PHASE(2, phase2(p, lds));       SEAM();
#endif
    RUN_PHASE(3, (phase3<true, true>(p, lds)));       SEAM();
#ifdef DUP_3A
    RUN_PHASE(3, (phase3<true, false>(p, lds)));       SEAM();
#endif
#ifdef DUP_3S
    RUN_PHASE(3, (phase3<false, true>(p, lds)));       SEAM();
#endif
    RUN_PHASE(4, phase4(p, lds));       SEAM();
#ifdef EMPTY_SEAMS
    SEAM(); SEAM(); SEAM(); SEAM();
#endif
    RUN_PHASE(5, phase5(p, lds));       SEAM();
    RUN_PHASE(6, phase6(p, lds));       SEAM();
#ifdef DUP_4
    RUN_PHASE(4, phase4(p, lds));       SEAM();
#endif
#ifdef DUP_5
    RUN_PHASE(5, phase5(p, lds));       SEAM();
#endif
#ifdef DUP_6
    RUN_PHASE(6, phase6(p, lds));       SEAM();
#endif
#ifdef DUP_456
    RUN_PHASE(4, phase4(p, lds));       SEAM();
    RUN_PHASE(5, phase5(p, lds));       SEAM();
    RUN_PHASE(6, phase6(p, lds));       SEAM();
#endif
#ifdef PRE_7
    RUN_PHASE(7, phase7<false>(p, lds));       SEAM();
#endif
    RUN_PHASE(7, phase7<true>(p, lds));       SEAM();
#ifdef DUP_7
    if (blockIdx.x < 8) ((int*)(p->ws + OFF_CNT))[blockIdx.x * 512 + threadIdx.x] = 0;
    SEAM();
    RUN_PHASE(7, phase7<true>(p, lds));       SEAM();
#endif
    RUN_PHASE(8, phase8(p, lds));       SEAM();
#ifdef DUP_8
    RUN_PHASE(8, phase8(p, lds));       SEAM();
#endif
    RUN_PHASE(9, phase9(p, lds));       SEAM();
#ifdef DUP_9
    RUN_PHASE(9, phase9(p, lds));       SEAM();
#endif
    RUN_PHASE(10, phase10(p, lds));
#undef RUN_PHASE
#undef SEAM
}

extern "C" void kernel_launch(void* const* d_in, const int* in_sizes, int n_in, void* d_out, int out_size, void* d_ws, size_t ws_size, hipStream_t stream) {
    static int grid_blocks = 0;
    if (grid_blocks == 0) {
        if (n_in != 31 || out_size != T * D || ws_size < WS_NEED) { fprintf(stderr, "kernel_launch: unexpected problem (n_in %d out %d ws %zu need %zu)\n", n_in, out_size, ws_size, (size_t)WS_NEED); grid_blocks = -1; return; }
        int dev = 0, cus = 0, per_cu = 0;
        hipGetDevice(&dev);
        hipDeviceGetAttribute(&cus, hipDeviceAttributeMultiprocessorCount, dev);
        if (hipFuncSetAttribute((const void*)hybrid_fwd, hipFuncAttributeMaxDynamicSharedMemorySize, LDS_BYTES) != hipSuccess) { fprintf(stderr, "kernel_launch: hipFuncSetAttribute failed\n"); grid_blocks = -1; return; }
        hipOccupancyMaxActiveBlocksPerMultiprocessor(&per_cu, (const void*)hybrid_fwd, NTHREADS, LDS_BYTES);
        if (per_cu < 1) { fprintf(stderr, "kernel_launch: occupancy query says %d blocks/CU\n", per_cu); grid_blocks = -1; return; }
        grid_blocks = cus;
    }
    if (grid_blocks < 0) return;
    Params p{};
    for (int i = 0; i < 31; ++i) p.in[i] = (const float*)d_in[i];
    p.out = (float*)d_out; p.ws = (unsigned char*)d_ws;
    for (int i = 0; i < 32; ++i) p.inv_freq[i] = std::pow(10000.0, -(double)i / 32.0);
    p.nseq = 11; p.use_grid_sync = 1;
    void* args[] = {&p};
    hipError_t e = hipLaunchCooperativeKernel((const void*)hybrid_fwd, dim3(grid_blocks), dim3(NTHREADS), args, LDS_BYTES, stream);
    if (e != hipSuccess) fprintf(stderr, "cooperative launch failed: %s (grid %d)\n", hipGetErrorString(e), grid_blocks);
}
```

```cpp
#include <hip/hip_runtime.h>
#include <hip/hip_cooperative_groups.h>
#include <cstdio>
#include <cmath>
namespace cg = cooperative_groups;

#define LAS __attribute__((address_space(3)))
#define DI __device__ __forceinline__
#define CAS __attribute__((address_space(4)))
typedef unsigned short bf16_t;
typedef short bf16x8 __attribute__((ext_vector_type(8)));
typedef float f32x16 __attribute__((ext_vector_type(16)));
typedef float f32x4 __attribute__((ext_vector_type(4)));
typedef float f32x2 __attribute__((ext_vector_type(2)));
typedef unsigned u32x4 __attribute__((ext_vector_type(4)));
typedef unsigned u32x2 __attribute__((ext_vector_type(2)));
typedef __bf16 bf16v2 __attribute__((ext_vector_type(2)));

constexpr int T = 16384, SEQ = 8192, NB = 2, D = 2048;
constexpr int DSSM = 1024, NG = 64, GC = 16, NS = 64;
constexpr int QL = 512, KVL = 256, NH = 8, QKD = 192, VD = 128;
constexpr int DINP = 6144;
constexpr int NE = 64, TOPK = 8, DE = 512;
constexpr float EPS = 1e-6f;
constexpr int NTHREADS = 512;
constexpr int LDS_BYTES = 143376;
constexpr int UT_OFF = 141312;
constexpr int XBST_OFF = 143360;
constexpr int SEGLEN = 256, NSEG = SEQ / SEGLEN;

constexpr size_t al(size_t x) { return (x + 255) & ~(size_t)255; }
constexpr size_t OFF_CNT   = 0;
constexpr size_t OFF_BAR   = 16384;
constexpr size_t OFF_XBAR  = 4096 + 16384;
constexpr size_t OFF_RSTD1 = OFF_XBAR + 16384;
constexpr size_t OFF_QSS   = al(OFF_RSTD1 + (size_t)T * 4);
constexpr size_t OFF_KSS   = al(OFF_QSS + (size_t)T * 16 * 4);
constexpr size_t OFF_SSQ2  = al(OFF_KSS + (size_t)T * 8 * 4);
constexpr size_t OFF_RSTD2 = al(OFF_SSQ2 + (size_t)T * 64 * 4);
constexpr size_t OFF_RS2   = al(OFF_RSTD2 + (size_t)T * 4);
constexpr size_t OFF_KPE   = al(OFF_RS2 + (size_t)NE * T * 4);
constexpr size_t OFF_CS    = al(OFF_KPE + (size_t)T * 64 * 4);
constexpr size_t OFF_LB    = al(OFF_CS + (size_t)T * 64 * 4);
constexpr size_t OFF_LBP   = al(OFF_LB + (size_t)NG * NS * 8);
constexpr size_t OFF_BB    = al(OFF_LBP + (size_t)NG * NS * 8);
constexpr size_t OFF_CM    = al(OFF_BB + (size_t)NG * 128 * 16 * 2);
constexpr size_t OFF_EST   = al(OFF_CM + (size_t)NG * 16 * 128 * 2);
constexpr size_t OFF_WRT   = al(OFF_EST + (size_t)NB * NG * NSEG * NS * 8);
constexpr size_t OFF_LIST  = al(OFF_WRT + (size_t)D * NE * 4);
constexpr size_t OFF_ROWW  = al(OFF_LIST + (size_t)NE * T * 4);
constexpr size_t OFF_TPOS  = al(OFF_ROWW + (size_t)NE * T * 4);
constexpr size_t OFF_WIN   = al(OFF_TPOS + (size_t)T * 8 * 4);
constexpr size_t OFF_WQUP  = al(OFF_WIN + (size_t)DINP * D * 2);
constexpr size_t OFF_WKVUP = al(OFF_WQUP + (size_t)1536 * 512 * 2);
constexpr size_t OFF_WVG   = al(OFF_WKVUP + (size_t)2048 * 256 * 2);
constexpr size_t OFF_WMLA  = al(OFF_WVG + (size_t)4096 * 1024 * 2);
constexpr size_t OFF_WOUT  = al(OFF_WMLA + (size_t)2048 * 1024 * 2);
constexpr size_t OFF_WDN8  = al(OFF_WOUT + (size_t)2048 * 2048 * 2);
constexpr size_t OFF_X1F8  = al(OFF_WDN8 + (size_t)65 * 2048 * 512);
constexpr size_t OFF_HID8  = al(OFF_X1F8 + (size_t)T * D);
constexpr size_t HID_ROWS  = (size_t)T * TOPK + T;
constexpr size_t OFF_SPAN  = al(OFF_HID8 + HID_ROWS * DE);
constexpr size_t OFF_WGU8  = OFF_SPAN;
constexpr size_t OFF_U     = al(OFF_WGU8 + (size_t)65 * 1024 * 2048);
constexpr size_t OFF_QLAT  = al(OFF_U + (size_t)T * 1024 * 2);
constexpr size_t OFF_KVLAT = al(OFF_QLAT + (size_t)T * 512 * 2);
constexpr size_t OFF_SG    = al(OFF_KVLAT + (size_t)T * 256 * 2);
constexpr size_t OFF_Q     = al(OFF_SG + (size_t)T * 4096 * 2);
constexpr size_t OFF_K     = al(OFF_Q + (size_t)T * NH * QKD * 2);
constexpr size_t OFF_VT    = al(OFF_K + (size_t)T * NH * QKD * 2);
constexpr size_t OFF_XB    = al(OFF_VT + (size_t)T * NH * VD * 2);
constexpr size_t OFF_YSSM  = al(OFF_XB + (size_t)T * D * 2);
constexpr size_t OFF_ATT   = al(OFF_YSSM + (size_t)T * 1024 * 2);
constexpr size_t OFF_MRG   = al(OFF_ATT + (size_t)T * 1024 * 2);
constexpr size_t WS_END    = al(OFF_MRG + (size_t)T * D * 2);
constexpr size_t OFF_Y     = OFF_SPAN;
constexpr size_t OFF_X8    = OFF_MRG;
constexpr size_t OFF_WIN8  = OFF_WIN + (size_t)2048 * D * 2;
constexpr size_t OFF_TMP   = OFF_Q;
constexpr size_t WS_NEED = (OFF_Y + HID_ROWS * D > WS_END) ? OFF_Y + HID_ROWS * D : WS_END;
static_assert(OFF_Y + HID_ROWS * D <= WS_END, "Y overlay inside the span");
static_assert(OFF_TMP + (size_t)T * D * 2 <= OFF_VT, "TMP inside Q|K");
static_assert(WS_NEED <= (size_t)1073741824, "workspace budget");
constexpr float WSCALE = 64.0f, HSCALE = 8.0f, YSCALE = 32.0f, SSCALE = 16.0f, XSCALE = 16.0f, ASCALE = 16.0f, MSCALE = 8.0f;

struct Params {
    const float* in[31];
    float* out;
    unsigned char* ws;
    double inv_freq[32];
    int seq[16];
    int nseq, use_grid_sync;
};
typedef const CAS Params* PP;

DI int tid_() { int t = threadIdx.x; asm volatile("" : "+v"(t)); return t; }
DI unsigned pk2(float lo, float hi) { f32x2 v = {lo, hi}; return __builtin_bit_cast(unsigned, __builtin_convertvector(v, bf16v2)); }
DI bf16_t f2bf(float x) { return (bf16_t)(pk2(x, 0.f) & 0xffffu); }
DI float clampf8(float x) { return fminf(fmaxf(x, -448.0f), 448.0f); }
DI unsigned pk4f8(float a, float b, float c, float d) {
    int r = __builtin_amdgcn_cvt_pk_fp8_f32(clampf8(a), clampf8(b), 0, false); r = __builtin_amdgcn_cvt_pk_fp8_f32(clampf8(c), clampf8(d), r, true); return (unsigned)r; }
DI float bf2f(unsigned u) { return __builtin_bit_cast(float, u << 16); }
DI float sigmoidf_(float x) { return 1.0f / (1.0f + __expf(-x)); }
DI float frcp_(float x) { return __builtin_amdgcn_rcpf(x); }
DI float sigmoidq_(float x) { return frcp_(1.0f + __expf(-x)); }
DI float silu_(float x) { return x * frcp_(1.0f + __expf(-x)); }
DI float gelu_tanh_(float x) { const float z = 0.7978845608028654f * (x + 0.044715f * x * x * x); const float e = __expf(2.0f * z); const float th = 1.0f - 2.0f * frcp_(e + 1.0f); return 0.5f * x * (1.0f + th); }
DI float sum_xor32(float x) {
    const auto s_ = __builtin_amdgcn_permlane32_swap(__builtin_bit_cast(unsigned, x), __builtin_bit_cast(unsigned, x), false, false);
    unsigned u0_ = s_[0], u1_ = s_[1]; asm volatile("" : "+v"(u0_), "+v"(u1_));
    return __builtin_bit_cast(float, u0_) + __builtin_bit_cast(float, u1_);
}
DI int swap23(int p) { return (p & 3) | ((p & 4) << 1) | ((p & 8) >> 1); }
#define MFMA32(a, b, c) __builtin_amdgcn_mfma_f32_32x32x16_bf16((a), (b), (c), 0, 0, 0)

DI double exp_d(double x) {
    const double k = __builtin_rint(x * 1.4426950408889634);
    const double r = __builtin_fma(-k, 1.9082149292705877e-10, __builtin_fma(-k, 6.93147180369123816490e-01, x));
    double p = 1.0;
#pragma unroll 1
    for (int n = 16; n >= 1; --n) p = __builtin_fma(p * r, 1.0 / (double)n, 1.0);
    const long long ki = (long long)k;
    const double sc = __builtin_bit_cast(double, (unsigned long long)(ki + 1023) << 52);
    return p * sc;
}
DI void sincos_d(double x, double& s, double& c) {
    const double k = __builtin_rint(x * 0.63661977236758134308);
    double r = __builtin_fma(-k, 1.57079632673412561417e+00, x);
    r = __builtin_fma(-k, 6.07710050650619224932e-11, r);
    const double r2 = r * r;
    double ps = 1.0, pc = 1.0;
#pragma unroll 1
    for (int n = 9; n >= 1; --n) {
        ps = __builtin_fma(-ps * r2, 1.0 / (double)((2 * n) * (2 * n + 1)), 1.0);
        pc = __builtin_fma(-pc * r2, 1.0 / (double)((2 * n - 1) * (2 * n)), 1.0);
    }
    const double sr = r * ps, cr = pc;
    const int q = (int)((long long)k & 3);
    s = (q == 0) ? sr : (q == 1) ? cr : (q == 2) ? -sr : -cr;
    c = (q == 0) ? cr : (q == 1) ? -sr : (q == 2) ? -cr : sr;
}

constexpr int ROWB = 144;
template <int WM, int WN, int MT, int NT, class ARow, class BRow>
DI void gemm_mainloop(LAS unsigned char* lds, const ARow& arow, const BRow& brow, const int K, f32x16 (&acc)[MT][NT]) {
    constexpr int BM = WM * MT * 32, BN = WN * NT * 32;
    constexpr int NA = BM * 8, NBc = BN * 8;
    constexpr int ACH = (NA + NTHREADS - 1) / NTHREADS, BCH = (NBc + NTHREADS - 1) / NTHREADS;
    constexpr int A_BYTES = BM * ROWB, STAGE = (BM + BN) * ROWB;
    static_assert(2 * STAGE <= LDS_BYTES, "gemm stages fit LDS");
    const int tid = tid_(), lane = tid & 63, wid = tid >> 6;
    __builtin_assume(tid >= 0 && tid < NTHREADS);
    const int wm = wid / WN, wn = wid % WN;
    const bf16_t* ap[ACH]; const bf16_t* bp[BCH];
    int aw[ACH], bw[BCH];
#pragma unroll
    for (int i = 0; i < ACH; ++i) { const int c = tid + NTHREADS * i; const bool v = c < NA; const int r = v ? (c >> 3) : 0; ap[i] = arow(r) + (c & 7) * 8; aw[i] = r * ROWB + (c & 7) * 16; }
#pragma unroll
    for (int i = 0; i < BCH; ++i) { const int c = tid + NTHREADS * i; const bool v = c < NBc; const int r = v ? (c >> 3) : 0; bp[i] = brow(r) + (c & 7) * 8; bw[i] = A_BYTES + r * ROWB + (c & 7) * 16; }
    const int aoff = (wm * MT * 32 + (lane & 31)) * ROWB + (lane >> 5) * 16;
    const int boff = A_BYTES + (wn * NT * 32 + (lane & 31)) * ROWB + (lane >> 5) * 16;
    u32x4 ra0[ACH], rb0[BCH], ra1[ACH], rb1[BCH];
    const int nk = K >> 6;
#define GM_LOAD(ra, rb, kt) do { _Pragma("unroll") for (int i = 0; i < ACH; ++i) ra[i] = *(const u32x4*)(ap[i] + (kt) * 64); \
        _Pragma("unroll") for (int i = 0; i < BCH; ++i) rb[i] = *(const u32x4*)(bp[i] + (kt) * 64); } while (0)
#define GM_STORE(ra, rb, off) do { _Pragma("unroll") for (int i = 0; i < ACH; ++i) if (tid + NTHREADS * i < NA) *(LAS u32x4*)(lds + (off) + aw[i]) = ra[i]; \
        _Pragma("unroll") for (int i = 0; i < BCH; ++i) if (tid + NTHREADS * i < NBc) *(LAS u32x4*)(lds + (off) + bw[i]) = rb[i]; } while (0)
#define GM_COMPUTE(cur) do { _Pragma("unroll") for (int ks = 0; ks < 4; ++ks) { bf16x8 af[MT], wf[NT]; \
        _Pragma("unroll") for (int mt = 0; mt < MT; ++mt) af[mt] = *(const LAS bf16x8*)(lds + (cur) + aoff + mt * 32 * ROWB + ks * 32); \
        _Pragma("unroll") for (int nt = 0; nt < NT; ++nt) wf[nt] = *(const LAS bf16x8*)(lds + (cur) + boff + nt * 32 * ROWB + ks * 32); \
        _Pragma("unroll") for (int mt = 0; mt < MT; ++mt) _Pragma("unroll") for (int nt = 0; nt < NT; ++nt) acc[mt][nt] = MFMA32(wf[nt], af[mt], acc[mt][nt]); } } while (0)
    GM_LOAD(ra0, rb0, 0);
    if (nk > 1) GM_LOAD(ra1, rb1, 1);
    GM_STORE(ra0, rb0, 0);
    __syncthreads();
#define GM_SYNC() do { asm volatile("s_waitcnt lgkmcnt(0)" ::: "memory"); __syncthreads(); } while (0)
    for (int kt = 0; kt < nk; kt += 2) {
        if (kt + 2 < nk) GM_LOAD(ra0, rb0, kt + 2);
        GM_COMPUTE(0);
        if (kt + 1 < nk) GM_STORE(ra1, rb1, STAGE);
        GM_SYNC();
        if (kt + 3 < nk) GM_LOAD(ra1, rb1, kt + 3);
        if (kt + 1 < nk) GM_COMPUTE(STAGE);
        if (kt + 2 < nk) GM_STORE(ra0, rb0, 0);
        GM_SYNC();
    }
#undef GM_SYNC
#undef GM_LOAD
#undef GM_STORE
#undef GM_COMPUTE
}
template <int MT, int NT> DI void zero_acc(f32x16 (&acc)[MT][NT]) {
#pragma unroll
    for (int a = 0; a < MT; ++a)
#pragma unroll
        for (int b = 0; b < NT; ++b)
#pragma unroll
            for (int r = 0; r < 16; ++r) acc[a][b][r] = 0.f;
}
struct RowLin { const bf16_t* base; size_t ld; DI const bf16_t* operator()(int r) const { return base + (size_t)r * ld; } };
struct RowGather { const bf16_t* base; size_t ld; const int* idx; int nvalid; DI const bf16_t* operator()(int r) const { const int rr = r < nvalid ? r : 0; return base + (size_t)idx[rr] * ld; } };


constexpr int PG_HTB = 128 * 64 * 2, PG_STAGE_BYTES = 8 * PG_HTB;
static_assert(PG_STAGE_BYTES + 2048 <= LDS_BYTES, "stage region + tables fit LDS");
DI int pg_lds_byte(int r, int c) { const int st = (r >> 4) * 2 + (c >> 5), rr = r & 15, cc = c & 31, ob = rr * 64 + cc * 2; return st * 1024 + (ob ^ (((ob >> 9) & 1) << 5)); }
DI void pg_stage_rc(int b, int& R, int& C) { const int st = b / 1024, sb = b % 1024, swz = sb ^ (((sb >> 9) & 1) << 5); R = (st >> 1) * 16 + swz / 64; C = (st & 1) * 32 + (swz % 64) / 2; }
DI int pg_perm32(int rho) { const int n = rho >> 4, i = rho & 15; return 8 * (i >> 2) + 4 * n + (i & 3); }
DI const char* sgpr_ptr(const char* p) { const unsigned lo = __builtin_amdgcn_readfirstlane((unsigned)(size_t)p), hi = __builtin_amdgcn_readfirstlane((unsigned)((size_t)p >> 32)); return (const char*)(((size_t)hi << 32) | (size_t)lo); }
struct PgUnit { const char* a; const char* b; const int* gidx; int nvalid; int i0, i1, i2, i3; };
typedef f32x4 PgAcc[2][2][4][2];
typedef int i32x8 __attribute__((ext_vector_type(8)));
template <bool PERM, bool F8, bool XH, class Sched, class Epi>
DI void pg_gemm_phase(LAS unsigned char* lds, const int KB, const Sched& S, const Epi& E) {
    const int tid = tid_(), wid = __builtin_amdgcn_readfirstlane(tid >> 6), lane = tid & 63, wr = wid >> 2, wc = wid & 3, fr = lane & 15, fq = lane >> 4;
    const int nt = KB / 128;
    int Rl[2], Cl[2]; unsigned voffB[2];
#pragma unroll
    for (int i = 0; i < 2; ++i) { pg_stage_rc(tid * 16 + i * 8192, Rl[i], Cl[i]); const int r31 = PERM ? pg_perm32(Rl[i] & 31) : (Rl[i] & 31); const int Rb = (XH ? (Rl[i] >> 5) * 64 : (Rl[i] & ~31)) + r31; voffB[i] = (unsigned)(Rb * KB + Cl[i] * 2); }
    const size_t kstep = 128, hstep = (size_t)(XH ? 32 : 128) * KB;
    const unsigned ldsw = (unsigned)wid * 1024u;
    const int aoff0 = pg_lds_byte(wr * 64 + fr, fq * 8), aoff1 = pg_lds_byte(wr * 64 + fr, fq * 8 + 32);
    const int boff0 = pg_lds_byte(wc * 32 + fr, fq * 8), boff1 = pg_lds_byte(wc * 32 + fr, fq * 8 + 32);
#define PG_SA(b, h) (((b) * 2 + (h)) * PG_HTB)
#define PG_SB(b, h) ((4 + (b) * 2 + (h)) * PG_HTB)
#define PG_STAGE(bufoff, gbase, v0, v1) do { \
        __builtin_amdgcn_global_load_lds((const unsigned*)((const char*)(gbase) + (v0)), (LAS unsigned*)(lds + (bufoff) + ldsw), 16, 0, 0); \
        __builtin_amdgcn_global_load_lds((const unsigned*)((const char*)(gbase) + (v1)), (LAS unsigned*)(lds + (bufoff) + ldsw + 8192), 16, 0, 0); } while (0)
#define PG_STAGE_B(bufoff, gbase) PG_STAGE(bufoff, gbase, voffB[0], voffB[1])
#define PG_LD8(dst, base0, base1) do { const u32x4 lo_ = *(const LAS u32x4*)(lds + (base0)), hi_ = *(const LAS u32x4*)(lds + (base1)); \
        dst = (i32x8){(int)lo_.x, (int)lo_.y, (int)lo_.z, (int)lo_.w, (int)hi_.x, (int)hi_.y, (int)hi_.z, (int)hi_.w}; } while (0)
#define PG_LDA(dst, b, h) do { _Pragma("unroll") for (int m = 0; m < 4; ++m) PG_LD8(dst[m], PG_SA(b, h) + aoff0 + m * 2048, PG_SA(b, h) + aoff1 + m * 2048); } while (0)
#define PG_LDB(dst, b, h) do { _Pragma("unroll") for (int n = 0; n < 2; ++n) PG_LD8(dst[n], PG_SB(b, h) + boff0 + n * 2048, PG_SB(b, h) + boff1 + n * 2048); } while (0)
#define PG_LO(v) __builtin_bit_cast(bf16x8, __builtin_shufflevector(v, v, 0, 1, 2, 3))
#define PG_HI(v) __builtin_bit_cast(bf16x8, __builtin_shufflevector(v, v, 4, 5, 6, 7))
#define PG_MMA(ai, bj, At, Bt) do { __builtin_amdgcn_s_setprio(1); _Pragma("unroll") for (int m = 0; m < 4; ++m) _Pragma("unroll") for (int n = 0; n < 2; ++n) { \
        if constexpr (F8) asm volatile("v_mfma_scale_f32_16x16x128_f8f6f4 %0, %1, %2, %0, %3, %3 op_sel_hi:[0,0,0]" : "+v"(acc[ai][bj][m][n]) : "v"(Bt[n]), "v"(At[m]), "v"(sc1_)); \
        else { acc[ai][bj][m][n] = __builtin_amdgcn_mfma_f32_16x16x32_bf16(PG_LO(Bt[n]), PG_LO(At[m]), acc[ai][bj][m][n], 0, 0, 0); \
               acc[ai][bj][m][n] = __builtin_amdgcn_mfma_f32_16x16x32_bf16(PG_HI(Bt[n]), PG_HI(At[m]), acc[ai][bj][m][n], 0, 0, 0); } } \
        __builtin_amdgcn_s_setprio(0); } while (0)
#define PG_WAIT_V(n) asm volatile("s_waitcnt vmcnt(" #n ")" ::: "memory")
#define PG_WAIT_L(n) asm volatile("s_waitcnt lgkmcnt(" #n ")" ::: "memory")
#define PG_BAR __builtin_amdgcn_s_barrier()
#define PG_SCHED __builtin_amdgcn_sched_barrier(0)
#define PG_AOFF(u, vo) do { int R_[2], C_[2]; { const int t_ = tid_(); pg_stage_rc(t_ * 16, R_[0], C_[0]); pg_stage_rc(t_ * 16 + 8192, R_[1], C_[1]); } \
        if ((u).gidx) { int g_[2][2]; \
            _Pragma("unroll") for (int hh = 0; hh < 2; ++hh) _Pragma("unroll") for (int i = 0; i < 2; ++i) { const int row = R_[i] + 128 * hh; g_[hh][i] = (u).gidx[row < (u).nvalid ? row : 0]; } \
            _Pragma("unroll") for (int hh = 0; hh < 2; ++hh) _Pragma("unroll") for (int i = 0; i < 2; ++i) vo[hh][i] = (unsigned)g_[hh][i] * (unsigned)KB + (unsigned)(C_[i] * 2); } \
        else { _Pragma("unroll") for (int hh = 0; hh < 2; ++hh) _Pragma("unroll") for (int i = 0; i < 2; ++i) vo[hh][i] = (unsigned)((R_[i] + 128 * hh) * KB + C_[i] * 2); } } while (0)
    PgUnit cur, nxt; int ui = 0;
    if (!S.next(0, cur)) return;
    PgAcc acc;
#pragma unroll
    for (int a = 0; a < 2; ++a)
#pragma unroll
        for (int b = 0; b < 2; ++b)
#pragma unroll
            for (int m = 0; m < 4; ++m)
#pragma unroll
                for (int n = 0; n < 2; ++n) { float z_ = 0.f; asm volatile("" : "+v"(z_)); acc[a][b][m][n] = (f32x4){z_, z_, z_, z_}; }
    i32x8 At[4], B0[2], B1[2];
    const int sc1_ = 0x7f7f7f7f;
    (void)sc1_;
    unsigned vo[2][2], w1s0, w1s1;
    PG_AOFF(cur, vo);
    const char* cA = sgpr_ptr(cur.a); const char* cB = sgpr_ptr(cur.b);
    PG_STAGE_B(PG_SB(0, 0), cB); PG_STAGE_B(PG_SB(0, 1), cB + hstep); PG_STAGE(PG_SA(0, 0), cA, vo[0][0], vo[0][1]); PG_STAGE(PG_SA(0, 1), cA, vo[1][0], vo[1][1]);
    if (wr == 1) PG_BAR;
    PG_WAIT_V(2); PG_BAR;
    PG_STAGE_B(PG_SB(1, 0), cB + kstep); PG_STAGE(PG_SA(1, 0), cA + kstep, vo[0][0], vo[0][1]); PG_STAGE_B(PG_SB(1, 1), cB + hstep + kstep);
    PG_WAIT_V(6); PG_BAR;
    for (;;) {
        const bool has_next = S.next(ui + 1, nxt);
        {
            unsigned nvo[2][2];
            if (has_next) { PG_AOFF(nxt, nvo); }
            else {
#pragma unroll
                for (int hh = 0; hh < 2; ++hh)
#pragma unroll
                    for (int i = 0; i < 2; ++i) nvo[hh][i] = vo[hh][i];
            }
            *(LAS u32x4*)(lds + PG_STAGE_BYTES + 2048 + tid_() * 16) = (u32x4){nvo[0][0], nvo[0][1], nvo[1][0], nvo[1][1]};
        }
        const char* nA = has_next ? sgpr_ptr(nxt.a) : cA; const char* nB = has_next ? sgpr_ptr(nxt.b) : cB;
#pragma unroll 1
        for (int t = 0; t < nt; t += 2) {
            const bool last = (t == nt - 2);
            const char* a1 = cA + (size_t)(t + 1) * kstep;
            const char* a2 = last ? nA : cA + (size_t)(t + 2) * kstep; const char* b2 = last ? nB : cB + (size_t)(t + 2) * kstep;
            const char* a3 = a2 + kstep; const char* b3 = b2 + kstep;
            if (last) { const u32x4 nv_ = *(const LAS u32x4*)(lds + PG_STAGE_BYTES + 2048 + tid_() * 16); vo[0][0] = nv_.x; vo[0][1] = nv_.y; w1s0 = vo[1][0]; w1s1 = vo[1][1]; vo[1][0] = nv_.z; vo[1][1] = nv_.w; } else { w1s0 = vo[1][0]; w1s1 = vo[1][1]; }
            const unsigned w00 = vo[0][0], w01 = vo[0][1], w10 = vo[1][0], w11 = vo[1][1];
            PG_LDB(B0, 0, 0); PG_LDB(B1, 0, 1); PG_SCHED; PG_LDA(At, 0, 0); PG_STAGE(PG_SA(1, 1), a1, w1s0, w1s1);
            PG_WAIT_V(8); PG_WAIT_L(0); PG_BAR; PG_MMA(0, 0, At, B0); PG_MMA(0, 1, At, B1); PG_BAR; PG_SCHED;
            PG_LDA(At, 0, 1); PG_STAGE_B(PG_SB(0, 0), b2); PG_STAGE_B(PG_SB(0, 1), b2 + hstep); PG_STAGE(PG_SA(0, 0), a2, w00, w01);
            PG_WAIT_V(8); PG_WAIT_L(0); PG_BAR; PG_MMA(1, 0, At, B0); PG_MMA(1, 1, At, B1); PG_BAR; PG_SCHED;
            PG_LDB(B0, 1, 0); PG_LDB(B1, 1, 1); PG_SCHED; PG_LDA(At, 1, 0); PG_STAGE(PG_SA(0, 1), a2, w10, w11);
            PG_WAIT_V(8); PG_WAIT_L(0); PG_BAR; PG_MMA(0, 0, At, B0); PG_MMA(0, 1, At, B1); PG_BAR; PG_SCHED;
            PG_LDA(At, 1, 1); PG_STAGE_B(PG_SB(1, 0), b3); PG_STAGE_B(PG_SB(1, 1), b3 + hstep); PG_STAGE(PG_SA(1, 0), a3, w00, w01);
            PG_WAIT_V(8); PG_WAIT_L(0); PG_BAR; PG_MMA(1, 0, At, B0); PG_MMA(1, 1, At, B1); PG_BAR; PG_SCHED;
        }
        if (wr == 0) PG_BAR;
        if constexpr (F8) asm volatile("s_nop 15\n\ts_nop 7" ::: "memory");
        E(acc, cur, wr, wc, fr, fq);
        if (!has_next) break;
#pragma unroll
        for (int a = 0; a < 2; ++a)
#pragma unroll
            for (int b = 0; b < 2; ++b)
#pragma unroll
                for (int m = 0; m < 4; ++m)
#pragma unroll
                    for (int n = 0; n < 2; ++n) { float z_ = 0.f; asm volatile("" : "+v"(z_)); acc[a][b][m][n] = (f32x4){z_, z_, z_, z_}; }
        if constexpr (F8) asm volatile("s_nop 7" ::: "memory");
        cur = nxt; cA = nA; cB = nB; ++ui;
        if (wr == 1) PG_BAR;
    }
    PG_WAIT_V(0);
    PG_BAR;
#undef PG_SA
#undef PG_SB
#undef PG_STAGE
#undef PG_STAGE_B
#undef PG_LDA
#undef PG_LDB
#undef PG_LD8
#undef PG_LO
#undef PG_HI
#undef PG_MMA
#undef PG_WAIT_V
#undef PG_WAIT_L
#undef PG_BAR
#undef PG_SCHED
#undef PG_AOFF
}
struct DenseOrder {
    const char* A; const char* B; int KB, nM, nN, nwg, G, c;
    DI bool next(int i, PgUnit& u) const {
        const long L = (long)i * G + c; if (L >= nwg) return false;
        int wgid = (int)L; { const int q = nwg / 8, r = nwg % 8, xcd = wgid % 8, off = wgid / 8; wgid = (xcd < r ? xcd * (q + 1) : r * (q + 1) + (xcd - r) * q) + off; }
        const int nig = 8 * nN, gid = wgid / nig, fm = gid * 8, gsz = (nM - fm) < 8 ? (nM - fm) : 8;
        const int pm = fm + ((wgid % nig) % gsz), pn = (wgid % nig) / gsz;
        u.a = A + (size_t)pm * 256 * KB; u.b = B + (size_t)pn * 256 * KB; u.gidx = nullptr; u.nvalid = 256; u.i0 = pm; u.i1 = pn; u.i2 = 0; u.i3 = 0; return true;
    }
};

template <int KPT, bool F8>
DI void conv_T(const float* src, int K, int N, int ld, void* dstv, const float* kscale, int rowmap, int slot, int nbatch, size_t src_bstride, size_t dst_bstride, long gtid, long gsize, LAS unsigned char* wl, int lane) {
    const long per = (long)(K / KPT) * N;
    const long total = per * nbatch;
    for (long c = gtid; c < total; c += gsize) {
        const int e = (int)(c / per); const long cc = c - (long)e * per;
        const int kb = (int)(cc / N), n = (int)(cc - (long)kb * N);
        const float* s = src + (size_t)e * src_bstride + (size_t)(kb * KPT) * ld + n;
        float v[KPT];
#pragma unroll
        for (int j = 0; j < KPT; ++j) v[j] = __builtin_nontemporal_load(s + (size_t)j * ld);
        if (kscale) {
#pragma unroll
            for (int j = 0; j < KPT; ++j) v[j] *= kscale[kb * KPT + j];
        }
        u32x4 o[8];
        if constexpr (F8) {
#pragma unroll
            for (int j = 0; j < 8; ++j) {
                o[j].x = pk4f8(v[16 * j] * WSCALE, v[16 * j + 1] * WSCALE, v[16 * j + 2] * WSCALE, v[16 * j + 3] * WSCALE); o[j].y = pk4f8(v[16 * j + 4] * WSCALE, v[16 * j + 5] * WSCALE, v[16 * j + 6] * WSCALE, v[16 * j + 7] * WSCALE);
                o[j].z = pk4f8(v[16 * j + 8] * WSCALE, v[16 * j + 9] * WSCALE, v[16 * j + 10] * WSCALE, v[16 * j + 11] * WSCALE); o[j].w = pk4f8(v[16 * j + 12] * WSCALE, v[16 * j + 13] * WSCALE, v[16 * j + 14] * WSCALE, v[16 * j + 15] * WSCALE); }
        } else {
#pragma unroll
            for (int j = 0; j < 8; ++j) { o[j].x = pk2(v[8 * j], v[8 * j + 1]); o[j].y = pk2(v[8 * j + 2], v[8 * j + 3]); o[j].z = pk2(v[8 * j + 4], v[8 * j + 5]); o[j].w = pk2(v[8 * j + 6], v[8 * j + 7]); }
        }
#pragma unroll
        for (int j = 0; j < 8; ++j) *(LAS u32x4*)(wl + lane * 144 + 16 * j) = o[j];
        asm volatile("s_waitcnt lgkmcnt(0)" ::: "memory");
        unsigned char* dbase = (unsigned char*)dstv + ((size_t)e * dst_bstride + (size_t)kb * KPT) * (F8 ? 1 : 2) + 16 * (lane & 7);
#pragma unroll
        for (int i = 0; i < 8; ++i) {
            const int r = 8 * i + (lane >> 3), nn = n - lane + r;
            int row = nn;
            if (rowmap == 1) row = (nn >= 1856) ? nn + 192 : nn;
            else if (rowmap == 2) row = ((nn >> 4) << 5) + slot * 16 + (nn & 15);
            const u32x4 t = *(const LAS u32x4*)(wl + r * 144 + 16 * (lane & 7));
            __builtin_nontemporal_store(t, (u32x4*)(dbase + (size_t)row * K * (F8 ? 1 : 2)));
        }
        asm volatile("s_waitcnt lgkmcnt(0)" ::: "memory");
    }
}

struct ConvDesc { int src, ks, K, N, rm, sl, nb, f8; unsigned long long dst, sb, db; int ld, n0; };
__device__ const ConvDesc conv_table[15] = {
    {3,  2,  D,    832,  0, 0, 1,  1, OFF_WIN,   0, 0, 5952, 1024},
    {3,  2,  D,    1024, 0, 0, 1,  1, OFF_WIN8 - (unsigned long long)1024 * D, 0, 0, 5952, 0},
    {3,  2,  D,    4096, 0, 0, 1,  1, OFF_WIN8,  0, 0, 5952, 1856},
    {5,  4,  QL,   1536, 0, 0, 1,  0, OFF_WQUP,  0, 0},
    {7,  6,  KVL,  2048, 0, 0, 1,  0, OFF_WKVUP, 0, 0},
    {18, -1, DSSM, D,    2, 0, 1,  1, OFF_WVG,   0, 0},
    {19, -1, DSSM, D,    2, 1, 1,  1, OFF_WVG,   0, 0},
    {20, -1, 1024, D,    0, 0, 1,  1, OFF_WMLA,  0, 0},
    {21, -1, D,    D,    0, 0, 1,  1, OFF_WOUT,  0, 0},
    {25, 22, D,    DE,   2, 0, NE, 1, OFF_WGU8,  (unsigned long long)D * DE, (unsigned long long)1024 * D},
    {26, 22, D,    DE,   2, 1, NE, 1, OFF_WGU8,  (unsigned long long)D * DE, (unsigned long long)1024 * D},
    {28, 22, D,    DE,   2, 0, 1,  1, OFF_WGU8 + (unsigned long long)NE * 1024 * D, 0, 0},
    {29, 22, D,    DE,   2, 1, 1,  1, OFF_WGU8 + (unsigned long long)NE * 1024 * D, 0, 0},
    {27, -1, DE,   D,    0, 0, NE, 1, OFF_WDN8,  (unsigned long long)DE * D, (unsigned long long)D * DE},
    {30, -1, DE,   D,    0, 0, 1,  1, OFF_WDN8 + (unsigned long long)NE * D * DE, 0, 0},
};
DI void phase0(PP p, LAS unsigned char* lds) {
    unsigned char* ws = p->ws;
    const long gtid = (long)blockIdx.x * NTHREADS + tid_(), gsize = (long)gridDim.x * NTHREADS;
    LAS unsigned char* wl = lds + ((int)(gtid & 511) >> 6) * 9216; const int lane0 = (int)(gtid & 63);
    if (gtid < 4096) ((int*)(ws + OFF_CNT))[gtid] = 0;
    for (int mi = 0; mi < 15; ++mi) {
        const ConvDesc cd = conv_table[mi];
        const int ld = cd.ld ? cd.ld : cd.N;
        if (cd.f8) conv_T<128, true>(p->in[cd.src] + cd.n0, cd.K, cd.N, ld, ws + cd.dst, cd.ks >= 0 ? p->in[cd.ks] : nullptr, cd.rm, cd.sl, cd.nb, cd.sb, cd.db, gtid, gsize, wl, lane0);
        else       conv_T<64, false>(p->in[cd.src] + cd.n0, cd.K, cd.N, ld, ws + cd.dst, cd.ks >= 0 ? p->in[cd.ks] : nullptr, cd.rm, cd.sl, cd.nb, cd.sb, cd.db, gtid, gsize, wl, lane0);
    }
    for (long c = gtid; c < (long)192 * D / 16; c += gsize) *(u32x4*)(ws + OFF_WIN + (size_t)832 * D + c * 16) = (u32x4){0u, 0u, 0u, 0u};
    { const float* wr = p->in[23]; const float* g2 = p->in[22]; float* o = (float*)(ws + OFF_WRT);
      for (long c = gtid; c < (long)D * NE; c += gsize) { const int j = (int)(c & 3), n = (int)(c >> 2) & 63, kk = (int)(c >> 8) & 3, S = (int)(c >> 10), k = 16 * S + 4 * kk + j; o[c] = wr[(size_t)k * NE + n] * g2[k]; } }
    { const int* pos = (const int*)p->in[1]; float* cs = (float*)(ws + OFF_CS);
      for (long c = gtid; c < (long)T * 32; c += gsize) { const int t = (int)(c >> 5), i = (int)(c & 31); double s, co; sincos_d((double)pos[t] * p->inv_freq[i], s, co); *(f32x2*)(cs + c * 2) = (f32x2){(float)co, (float)s}; } }
    { const float *a_re = p->in[10], *a_im = p->in[11], *log_dt = p->in[12], *b_re = p->in[13], *b_im = p->in[14], *c_re = p->in[15], *c_im = p->in[16];
      float* LB = (float*)(ws + OFF_LB); float* LBP = (float*)(ws + OFF_LBP); bf16_t* BB = (bf16_t*)(ws + OFF_BB); bf16_t* CM = (bf16_t*)(ws + OFF_CM);
      for (long c = gtid; c < (long)NG * NS; c += gsize) {
          const int g = (int)(c >> 6), n = (int)(c & 63);
          const double dt = exp_d((double)log_dt[g]);
          double lre = (double)a_re[c]; if (lre > -1e-4) lre = -1e-4;
          const double lim = (double)a_im[c];
          const double mag = exp_d(lre * dt); double sn, cn; sincos_d(lim * dt, sn, cn);
          const double lbr = mag * cn, lbi = mag * sn;
          const double den = lre * lre + lim * lim, nre = lbr - 1.0;
          const double cfr = (nre * lre + lbi * lim) / den, cfi = (lbi * lre - nre * lim) / den;
          LB[c * 2] = (float)lbr; LB[c * 2 + 1] = (float)lbi;
          double pr = lbr, pi = lbi;
#pragma unroll 1
          for (int i = 0; i < 8; ++i) { const double nr = pr * pr - pi * pi, ni = 2.0 * pr * pi; pr = nr; pi = ni; }
          LBP[c * 2] = (float)pr; LBP[c * 2 + 1] = (float)pi;
#pragma unroll
          for (int ch = 0; ch < GC; ++ch) {
              const double br = (double)b_re[c * GC + ch], bi = (double)b_im[c * GC + ch];
              BB[((size_t)g * 128 + n) * 16 + ch] = f2bf((float)(cfr * br - cfi * bi));
              BB[((size_t)g * 128 + 64 + n) * 16 + ch] = f2bf((float)(cfr * bi + cfi * br));
          }
      }
      for (long c = gtid; c < (long)NG * GC * NS; c += gsize) {
          const int gc_ = (int)(c >> 6), n = (int)(c & 63);
          CM[(size_t)gc_ * 128 + n] = f2bf(c_re[c]);
          CM[(size_t)gc_ * 128 + 64 + n] = f2bf(-c_im[c]);
      } }
    { const float* x = p->in[0]; float* rstd1 = (float*)(ws + OFF_RSTD1); unsigned* x8 = (unsigned*)(ws + OFF_X8);
      const int tid = tid_(); const int lane = tid & 63; const int gw = blockIdx.x * 8 + (tid >> 6), ngw = gridDim.x * 8;
      for (int row = gw; row < T; row += ngw) {
          const f32x4* xr = (const f32x4*)(x + (size_t)row * D) + lane;
          f32x4 v[8]; float s = 0.f;
#pragma unroll
          for (int j = 0; j < 8; ++j) { v[j] = __builtin_nontemporal_load(xr + 64 * j); s += v[j].x * v[j].x + v[j].y * v[j].y + v[j].z * v[j].z + v[j].w * v[j].w; }
#pragma unroll
          for (int o = 1; o < 64; o <<= 1) s += __shfl_xor(s, o);
          if (lane == 0) rstd1[row] = 1.0f / sqrtf(s * (1.0f / D) + EPS);
#pragma unroll
          for (int j = 0; j < 8; ++j) { x8[(size_t)row * (D / 4) + 64 * j + lane] = pk4f8(v[j].x * XSCALE, v[j].y * XSCALE, v[j].z * XSCALE, v[j].w * XSCALE); }
      } }
}

struct EpiInProj {
    const float* rstd1; bf16_t* U; bf16_t* QLAT; bf16_t* KVLAT; bf16_t* SG; float* QSS; float* KSS; float* KPE;
    DI void operator()(const PgAcc& acc, const PgUnit& u, int wr, int wc, int fr, int fq) const {
        const int pm = u.i0, pn = u.i1 + 4;
        float rsv[8];
#pragma unroll
        for (int q = 0; q < 8; ++q) rsv[q] = rstd1[pm * 256 + (q >> 2) * 128 + wr * 64 + (q & 3) * 16 + fr] * (1.0f / (XSCALE * WSCALE));
#pragma unroll
        for (int ai = 0; ai < 2; ++ai)
#pragma unroll
            for (int m = 0; m < 4; ++m) {
                const int row = pm * 256 + ai * 128 + wr * 64 + m * 16 + fr;
                const float rs = rsv[ai * 4 + m];
#pragma unroll
                for (int bj = 0; bj < 2; ++bj) {
                    const int cl = bj * 128 + wc * 32 + 8 * fq;
                    const f32x4 v0 = acc[ai][bj][m][0] * rs, v1 = acc[ai][bj][m][1] * rs;
                    if (pn == 7) {
                        if (bj == 0 && wc < 2) { *(f32x4*)(KPE + (size_t)row * 64 + cl) = v0; *(f32x4*)(KPE + (size_t)row * 64 + cl + 4) = v1; }
                    } else {
                        const u32x4 o = {pk2(v0[0], v0[1]), pk2(v0[2], v0[3]), pk2(v1[0], v1[1]), pk2(v1[2], v1[3])};
                        {
                            float ssq = v0[0] * v0[0] + v0[1] * v0[1] + v0[2] * v0[2] + v0[3] * v0[3] + v1[0] * v1[0] + v1[1] * v1[1] + v1[2] * v1[2] + v1[3] * v1[3];
                            ssq += __shfl_xor(ssq, 16); ssq += __shfl_xor(ssq, 32);
                            if (pn < 6) { *(u32x4*)(QLAT + (size_t)row * 512 + (pn - 4) * 256 + cl) = o; if (fq == 0) QSS[(size_t)row * 16 + (pn - 4) * 8 + bj * 4 + wc] = ssq; }
                            else        { *(u32x4*)(KVLAT + (size_t)row * 256 + cl) = o; if (fq == 0) KSS[(size_t)row * 8 + bj * 4 + wc] = ssq; }
                        }
                    }
                }
            }
    }
};
struct EpiGate {
    const float* rstd1; bf16_t* SG; bf16_t* U;
    DI void operator()(const PgAcc& acc, const PgUnit& u, int wr, int wc, int fr, int fq) const {
        const int pm = u.i0, pn = u.i1;
        float rsv[8];
#pragma unroll
        for (int q = 0; q < 8; ++q) rsv[q] = rstd1[pm * 256 + (q >> 2) * 128 + wr * 64 + (q & 3) * 16 + fr] * (1.0f / (XSCALE * WSCALE));
#pragma unroll
        for (int ai = 0; ai < 2; ++ai)
#pragma unroll
            for (int m = 0; m < 4; ++m) {
                const int row = pm * 256 + ai * 128 + wr * 64 + m * 16 + fr;
                const float rs = rsv[ai * 4 + m];
#pragma unroll
                for (int bj = 0; bj < 2; ++bj) {
                    const int cl = bj * 128 + wc * 32 + 8 * fq;
                    const f32x4 v0 = acc[ai][bj][m][0] * rs, v1 = acc[ai][bj][m][1] * rs;
                    if (pn < 4) { const u32x4 o = {pk2(v0[0], v0[1]), pk2(v0[2], v0[3]), pk2(v1[0], v1[1]), pk2(v1[2], v1[3])}; *(u32x4*)(U + (size_t)row * 1024 + pn * 256 + cl) = o; }
                    else { const u32x4 o = {pk2(sigmoidq_(v0[0]), sigmoidq_(v0[1])), pk2(sigmoidq_(v0[2]), sigmoidq_(v0[3])), pk2(sigmoidq_(v1[0]), sigmoidq_(v1[1])), pk2(sigmoidq_(v1[2]), sigmoidq_(v1[3]))};
                        *(u32x4*)(SG + (size_t)row * 4096 + (pn - 4) * 256 + cl) = o; }
                }
            }
    }
};
DI void phase1(PP p, LAS unsigned char* lds) {
    unsigned char* ws = p->ws;
    {
        const EpiInProj E{(const float*)(ws + OFF_RSTD1), (bf16_t*)(ws + OFF_U), (bf16_t*)(ws + OFF_QLAT), (bf16_t*)(ws + OFF_KVLAT), (bf16_t*)(ws + OFF_SG), (float*)(ws + OFF_QSS), (float*)(ws + OFF_KSS), (float*)(ws + OFF_KPE)};
        const DenseOrder S{(const char*)(ws + OFF_X8), (const char*)(ws + OFF_WIN), D, T / 256, 4, (T / 256) * 4, (int)gridDim.x, (int)blockIdx.x};
        pg_gemm_phase<true, true, false>(lds, D, S, E);
    }
    {
        const EpiGate E{(const float*)(ws + OFF_RSTD1), (bf16_t*)(ws + OFF_SG), (bf16_t*)(ws + OFF_U)};
        const DenseOrder S{(const char*)(ws + OFF_X8), (const char*)(ws + OFF_WIN8 - (size_t)1024 * D), D, T / 256, 20, (T / 256) * 20, (int)gridDim.x, (int)blockIdx.x};
        pg_gemm_phase<true, true, false>(lds, D, S, E);
    }
}

template <bool FULL>
DI void ssm_item(PP p, LAS unsigned char* wlds, int item, int lane) {
    unsigned char* ws = p->ws;
    asm volatile("" : "+v"(lane));
    const int g = (item / NSEG) % NG, b = item / (NSEG * NG);
    const int seg = (b == 0) ? item % NSEG : NSEG - 1 - item % NSEG;
    const int c = lane & 31, h = lane >> 5;
    const bf16_t* U = (const bf16_t*)(ws + OFF_U);
    const float* LB = (const float*)(ws + OFF_LB); const float* LBP = (const float*)(ws + OFF_LBP);
    const bf16_t* BB = (const bf16_t*)(ws + OFF_BB); const bf16_t* CM = (const bf16_t*)(ws + OFF_CM);
    float* EST = (float*)(ws + OFF_EST);
    const f32x2 l0 = *(const f32x2*)(LB + ((size_t)g * 64 + c) * 2), l1 = *(const f32x2*)(LB + ((size_t)g * 64 + c + 32) * 2);
    bf16x8 bfr[4];
#pragma unroll
    for (int jt = 0; jt < 4; ++jt) bfr[jt] = *(const bf16x8*)(BB + ((size_t)g * 128 + jt * 32 + c) * 16 + 8 * h);
    float s0r = 0.f, s0i = 0.f, s1r = 0.f, s1i = 0.f;
    const size_t ebase = ((size_t)(b * NG + g) * NSEG) * 64;
    bf16x8 cfr[4];
    if (FULL) {
        const f32x2 p0 = *(const f32x2*)(LBP + ((size_t)g * 64 + c) * 2), p1 = *(const f32x2*)(LBP + ((size_t)g * 64 + c + 32) * 2);
#pragma unroll 1
        for (int j0 = 0; j0 < seg; j0 += 8) {
            f32x2 e0[8], e1[8];
#pragma unroll
            for (int k = 0; k < 8; ++k) { const int jj = (j0 + k < NSEG) ? j0 + k : NSEG - 1; e0[k] = *(const f32x2*)(EST + (ebase + (size_t)jj * 64 + c) * 2); e1[k] = *(const f32x2*)(EST + (ebase + (size_t)jj * 64 + c + 32) * 2); }
#pragma unroll
            for (int k = 0; k < 8; ++k) if (j0 + k < seg) {
                const float a = p0.x * s0r - p0.y * s0i + e0[k].x, bb_ = p0.x * s0i + p0.y * s0r + e0[k].y; s0r = a; s0i = bb_;
                const float cc = p1.x * s1r - p1.y * s1i + e1[k].x, dd = p1.x * s1i + p1.y * s1r + e1[k].y; s1r = cc; s1i = dd;
            }
        }
#pragma unroll
        for (int ks = 0; ks < 4; ++ks) cfr[ks] = *(const bf16x8*)(CM + ((size_t)g * 16 + (lane & 15)) * 128 + ks * 32 + 8 * (lane >> 4));
    }
    const size_t m0 = (size_t)b * SEQ + (size_t)seg * SEGLEN;
    if constexpr (!FULL) {
#define CMUL(ar, ai, br, bi, cr, ci) do { const float tr_ = (ar) * (br) - (ai) * (bi), ti_ = (ar) * (bi) + (ai) * (br); cr = tr_; ci = ti_; } while (0)
        float w0r[16], w0i[16], w1r[16], w1i[16], L0r, L0i, L1r, L1i;
        {
            float a2r, a2i, a3r, a3i, a4r, a4i, a8r, a8i, a16r, a16i, a24r, a24i, b2r, b2i, b3r, b3i, b4r, b4i, b8r, b8i, b16r, b16i, b24r, b24i;
            CMUL(l0.x, l0.y, l0.x, l0.y, a2r, a2i); CMUL(a2r, a2i, l0.x, l0.y, a3r, a3i); CMUL(a2r, a2i, a2r, a2i, a4r, a4i); CMUL(a4r, a4i, a4r, a4i, a8r, a8i); CMUL(a8r, a8i, a8r, a8i, a16r, a16i); CMUL(a16r, a16i, a8r, a8i, a24r, a24i);
            CMUL(l1.x, l1.y, l1.x, l1.y, b2r, b2i); CMUL(b2r, b2i, l1.x, l1.y, b3r, b3i); CMUL(b2r, b2i, b2r, b2i, b4r, b4i); CMUL(b4r, b4i, b4r, b4i, b8r, b8i); CMUL(b8r, b8i, b8r, b8i, b16r, b16i); CMUL(b16r, b16i, b8r, b8i, b24r, b24i);
            CMUL(a16r, a16i, a16r, a16i, L0r, L0i); CMUL(b16r, b16i, b16r, b16i, L1r, L1i);
            const float f0r = h ? 1.0f : a4r, f0i = h ? 0.0f : a4i, f1r = h ? 1.0f : b4r, f1i = h ? 0.0f : b4i;
#pragma unroll
            for (int q = 0; q < 4; ++q) {
                float g0r, g0i, g1r, g1i;
                if (q == 3) { g0r = f0r; g0i = f0i; g1r = f1r; g1i = f1i; }
                else if (q == 2) { CMUL(f0r, f0i, a8r, a8i, g0r, g0i); CMUL(f1r, f1i, b8r, b8i, g1r, g1i); }
                else if (q == 1) { CMUL(f0r, f0i, a16r, a16i, g0r, g0i); CMUL(f1r, f1i, b16r, b16i, g1r, g1i); }
                else { CMUL(f0r, f0i, a24r, a24i, g0r, g0i); CMUL(f1r, f1i, b24r, b24i, g1r, g1i); }
                w0r[4 * q + 3] = g0r; w0i[4 * q + 3] = g0i; w1r[4 * q + 3] = g1r; w1i[4 * q + 3] = g1i;
                CMUL(g0r, g0i, l0.x, l0.y, w0r[4 * q + 2], w0i[4 * q + 2]); CMUL(g1r, g1i, l1.x, l1.y, w1r[4 * q + 2], w1i[4 * q + 2]);
                CMUL(g0r, g0i, a2r, a2i, w0r[4 * q + 1], w0i[4 * q + 1]);   CMUL(g1r, g1i, b2r, b2i, w1r[4 * q + 1], w1i[4 * q + 1]);
                CMUL(g0r, g0i, a3r, a3i, w0r[4 * q], w0i[4 * q]);           CMUL(g1r, g1i, b3r, b3i, w1r[4 * q], w1i[4 * q]);
            }
        }
#pragma unroll 1
        for (int sc = 0; sc < SEGLEN / 32; ++sc) {
            const bf16x8 ufr = *(const bf16x8*)(U + (m0 + sc * 32 + c) * 1024 + g * 16 + 8 * h);
            f32x16 a[4];
#pragma unroll
            for (int jt = 0; jt < 4; ++jt) {
#pragma unroll
                for (int r = 0; r < 16; ++r) a[jt][r] = 0.f;
                a[jt] = MFMA32(ufr, bfr[jt], a[jt]);
            }
            float p0r = 0.f, p0i = 0.f, p1r = 0.f, p1i = 0.f;
#pragma unroll
            for (int r = 0; r < 16; ++r) {
                p0r += w0r[r] * a[0][r] - w0i[r] * a[2][r]; p0i += w0r[r] * a[2][r] + w0i[r] * a[0][r];
                p1r += w1r[r] * a[1][r] - w1i[r] * a[3][r]; p1i += w1r[r] * a[3][r] + w1i[r] * a[1][r];
            }
            p0r = sum_xor32(p0r); p0i = sum_xor32(p0i); p1r = sum_xor32(p1r); p1i = sum_xor32(p1i);
            { const float nr = L0r * s0r - L0i * s0i + p0r, ni = L0r * s0i + L0i * s0r + p0i; s0r = nr; s0i = ni; }
            { const float nr = L1r * s1r - L1i * s1i + p1r, ni = L1r * s1i + L1i * s1r + p1i; s1r = nr; s1i = ni; }
        }
#undef CMUL
    } else {
#pragma unroll 1
    for (int sc = 0; sc < SEGLEN / 32; ++sc) {
        const bf16x8 ufr = *(const bf16x8*)(U + (m0 + sc * 32 + c) * 1024 + g * 16 + 8 * h);
        f32x16 a[4];
#pragma unroll
        for (int jt = 0; jt < 4; ++jt) {
#pragma unroll
            for (int r = 0; r < 16; ++r) a[jt][r] = 0.f;
            a[jt] = MFMA32(ufr, bfr[jt], a[jt]);
        }
#pragma unroll
        for (int q = 0; q < 4; ++q) {
#pragma unroll
            for (int o = 0; o < 2; ++o) {
                const bool own = (h == o);
#pragma unroll
                for (int j = 0; j < 4; ++j) {
                    const int r = 4 * q + j;
                    const float n0r = l0.x * s0r - l0.y * s0i + a[0][r], n0i = l0.x * s0i + l0.y * s0r + a[2][r];
                    const float n1r = l1.x * s1r - l1.y * s1i + a[1][r], n1i = l1.x * s1i + l1.y * s1r + a[3][r];
                    s0r = n0r; s0i = n0i; s1r = n1r; s1i = n1i;
                    if (FULL) { a[0][r] = own ? n0r : a[0][r]; a[2][r] = own ? n0i : a[2][r]; a[1][r] = own ? n1r : a[1][r]; a[3][r] = own ? n1i : a[3][r]; }
                }
                const float x0 = __shfl_xor(s0r, 32), x1 = __shfl_xor(s0i, 32), x2 = __shfl_xor(s1r, 32), x3 = __shfl_xor(s1i, 32);
                s0r = own ? s0r : x0; s0i = own ? s0i : x1; s1r = own ? s1r : x2; s1i = own ? s1i : x3;
            }
        }
        if (FULL) {
#pragma unroll
            for (int jt = 0; jt < 4; ++jt)
#pragma unroll
                for (int r = 0; r < 16; ++r) { const int t = (r & 3) + 8 * (r >> 2) + 4 * h; *(LAS bf16_t*)(wlds + (t * 136 + jt * 32 + c) * 2) = f2bf(a[jt][r]); }
            asm volatile("s_waitcnt lgkmcnt(0)" ::: "memory");
            const float* dvec = p->in[17]; unsigned char* YS = ws + OFF_YSSM;
            const int ch = lane & 15, tq = lane >> 4;
            const float dch = dvec[g * 16 + ch];
#pragma unroll
            for (int mt = 0; mt < 2; ++mt) {
                f32x4 y = {0.f, 0.f, 0.f, 0.f};
#pragma unroll
                for (int ks = 0; ks < 4; ++ks) {
                    const bf16x8 sf = *(const LAS bf16x8*)(wlds + ((mt * 16 + (lane & 15)) * 136 + ks * 32 + 8 * tq) * 2);
                    y = __builtin_amdgcn_mfma_f32_16x16x32_bf16(sf, cfr[ks], y, 0, 0, 0);
                }
#pragma unroll
                for (int i = 0; i < 4; ++i) {
                    const size_t m = m0 + sc * 32 + mt * 16 + 4 * tq + i;
                    const float uu = bf2f(U[m * 1024 + g * 16 + ch]);
                    YS[m * 1024 + g * 16 + ch] = (unsigned char)(pk4f8(gelu_tanh_(y[i] + dch * uu) * SSCALE, 0.f, 0.f, 0.f) & 0xffu);
                }
            }
            asm volatile("s_waitcnt lgkmcnt(0)" ::: "memory");
        }
    }
    }
    if (!FULL && h == 0) {
        *(f32x2*)(EST + (ebase + (size_t)seg * 64 + c) * 2) = (f32x2){s0r, s0i};
        *(f32x2*)(EST + (ebase + (size_t)seg * 64 + c + 32) * 2) = (f32x2){s1r, s1i};
    }
}

constexpr float QSCALE = 0.07216878364870322f * 1.4426950408889634f;
constexpr int EROWB = 400;
DI void phase2(PP p, LAS unsigned char* lds) {
    unsigned char* ws = p->ws;
    const int tid = tid_(), lane = tid & 63, wid = tid >> 6, h = lane >> 5, lm = lane & 31;
    const float* CS = (const float*)(ws + OFF_CS);
    {
        const bf16_t* QLAT = (const bf16_t*)(ws + OFF_QLAT); const bf16_t* WQ = (const bf16_t*)(ws + OFF_WQUP);
        const float* QSS = (const float*)(ws + OFF_QSS); const float* qg = p->in[8];
        bf16_t* Q = (bf16_t*)(ws + OFF_Q);
        for (int u0 = blockIdx.x; u0 < (T / 256) * NH; u0 += gridDim.x) {
            int u = u0; if ((gridDim.x & 7) == 0 && ((T / 256) * NH) % (int)gridDim.x == 0) { const int x = u0 & 7, L = ((u0 / (int)gridDim.x) * ((int)gridDim.x >> 3)) + (((u0 % (int)gridDim.x)) >> 3); u = x * 64 + L; }
            const int pm = u >> 3, hd = u & 7;
            f32x16 acc[1][6]; zero_acc(acc);
            gemm_mainloop<8, 1, 1, 6>(lds, RowLin{QLAT + (size_t)pm * 256 * QL, (size_t)QL}, RowLin{WQ + (size_t)hd * QKD * QL, (size_t)QL}, QL, acc);
            const int m = pm * 256 + wid * 32 + lm;
            float sq = 0.f;
#pragma unroll
            for (int i = 0; i < 16; ++i) sq += QSS[(size_t)m * 16 + i];
            const float rq = 1.0f / sqrtf(sq * (1.0f / QL) + EPS);
            float ssq = 0.f;
#pragma unroll
            for (int nt = 0; nt < 6; ++nt)
#pragma unroll
                for (int r = 0; r < 16; ++r) { acc[0][nt][r] *= rq; ssq += acc[0][nt][r] * acc[0][nt][r]; }
            ssq += __shfl_xor(ssq, 32);
            const float rh = QSCALE / sqrtf(ssq * (1.0f / QKD) + EPS);
            LAS unsigned char* er = lds + wid * (32 * EROWB);
            LAS bf16_t* qrow = (LAS bf16_t*)(er + lm * EROWB);
            int ho = h; asm volatile("" : "+v"(ho));
            const float* qgo = qg + 4 * ho;
            asm volatile("" :: "v"(rh) : "memory");
#pragma unroll
            for (int nt = 0; nt < 4; ++nt) {
                if (nt == 2) asm volatile("" ::: "memory");
#pragma unroll
                for (int q = 0; q < 4; ++q) {
                    const int d = nt * 32 + 8 * q + 4 * h;
                    const f32x4 g4 = *(const f32x4*)(qgo + nt * 32 + 8 * q);
                    *(LAS u32x2*)(qrow + d) = (u32x2){pk2(acc[0][nt][4 * q] * rh * g4.x, acc[0][nt][4 * q + 1] * rh * g4.y), pk2(acc[0][nt][4 * q + 2] * rh * g4.z, acc[0][nt][4 * q + 3] * rh * g4.w)};
                }
            }
            asm volatile("" ::: "memory");
#pragma unroll
            for (int q = 0; q < 4; ++q) {
                const int i0 = 8 * q + 4 * h;
                const f32x4 ga = *(const f32x4*)(qgo + 128 + 8 * q), gb = *(const f32x4*)(qgo + 160 + 8 * q);
                const f32x4 csA = *(const f32x4*)(CS + ((size_t)m * 32 + i0) * 2), csB = *(const f32x4*)(CS + ((size_t)m * 32 + i0 + 2) * 2);
                const float x10 = acc[0][4][4 * q] * rh * ga.x, x11 = acc[0][4][4 * q + 1] * rh * ga.y, x12 = acc[0][4][4 * q + 2] * rh * ga.z, x13 = acc[0][4][4 * q + 3] * rh * ga.w;
                const float x20 = acc[0][5][4 * q] * rh * gb.x, x21 = acc[0][5][4 * q + 1] * rh * gb.y, x22 = acc[0][5][4 * q + 2] * rh * gb.z, x23 = acc[0][5][4 * q + 3] * rh * gb.w;
                *(LAS u32x2*)(qrow + 128 + i0) = (u32x2){pk2(x10 * csA.x - x20 * csA.y, x11 * csA.z - x21 * csA.w), pk2(x12 * csB.x - x22 * csB.y, x13 * csB.z - x23 * csB.w)};
                *(LAS u32x2*)(qrow + 160 + i0) = (u32x2){pk2(x20 * csA.x + x10 * csA.y, x21 * csA.z + x11 * csA.w), pk2(x22 * csB.x + x12 * csB.y, x23 * csB.z + x13 * csB.w)};
            }
            asm volatile("s_waitcnt lgkmcnt(0)" ::: "memory");
            { const int m0w = pm * 256 + wid * 32, b = m0w / SEQ, s0 = m0w % SEQ;
              unsigned char* gdst = (unsigned char*)(Q + ((size_t)(b * NH + hd) * SEQ + s0) * QKD);
#pragma unroll
              for (int k = 0; k < 12; ++k) { const int off = (k * 64 + lane) * 16, row = off / 384, col = off - row * 384; *(u32x4*)(gdst + off) = *(const LAS u32x4*)(er + row * EROWB + col); } }
            asm volatile("s_waitcnt lgkmcnt(0)" ::: "memory"); __syncthreads();
        }
    }
    {
        const bf16_t* KVLAT = (const bf16_t*)(ws + OFF_KVLAT); const bf16_t* WKV = (const bf16_t*)(ws + OFF_WKVUP);
        const float* KSS = (const float*)(ws + OFF_KSS); const float* KPE = (const float*)(ws + OFF_KPE); const float* kg = p->in[9];
        bf16_t* Kb = (bf16_t*)(ws + OFF_K); bf16_t* VT = (bf16_t*)(ws + OFF_VT);
        for (int u0 = blockIdx.x; u0 < (T / 256) * NH * 2; u0 += gridDim.x) {
            int u = u0; if ((gridDim.x & 7) == 0 && ((T / 256) * NH * 2) % (int)gridDim.x == 0) { const int x = u0 & 7, L = ((u0 / (int)gridDim.x) * ((int)gridDim.x >> 3)) + (((u0 % (int)gridDim.x)) >> 3); u = x * 128 + L; }
            const int part = u & 1, hd = (u >> 1) & 7, pm = u >> 4;
            f32x16 acc[1][4]; zero_acc(acc);
            gemm_mainloop<8, 1, 1, 4>(lds, RowLin{KVLAT + (size_t)pm * 256 * KVL, (size_t)KVL}, RowLin{WKV + ((size_t)hd * 256 + part * 128) * KVL, (size_t)KVL}, KVL, acc);
            const int m = pm * 256 + wid * 32 + lm;
            float skv = 0.f;
#pragma unroll
            for (int i = 0; i < 8; ++i) skv += KSS[(size_t)m * 8 + i];
            const float rkv = 1.0f / sqrtf(skv * (1.0f / KVL) + EPS);
            const int b = m / SEQ, s = m % SEQ;
            if (part == 0) {
                float ssq = 0.f;
#pragma unroll
                for (int nt = 0; nt < 4; ++nt)
#pragma unroll
                    for (int r = 0; r < 16; ++r) { acc[0][nt][r] *= rkv; ssq += acc[0][nt][r] * acc[0][nt][r]; }
                const float* kpr = KPE + (size_t)m * 64 + 16 * h;
#pragma unroll
                for (int j = 0; j < 4; ++j) { const f32x4 a4 = *(const f32x4*)(kpr + 4 * j), b4 = *(const f32x4*)(kpr + 32 + 4 * j);
                    ssq += a4.x * a4.x + a4.y * a4.y + a4.z * a4.z + a4.w * a4.w + b4.x * b4.x + b4.y * b4.y + b4.z * b4.z + b4.w * b4.w; }
                ssq += __shfl_xor(ssq, 32);
                const float rk = 1.0f / sqrtf(ssq * (1.0f / QKD) + EPS);
                LAS unsigned char* er = lds + wid * (32 * EROWB);
                LAS bf16_t* krow = (LAS bf16_t*)(er + lm * EROWB);
                int ho = h; asm volatile("" : "+v"(ho));
                asm volatile("" :: "v"(rk) : "memory");
#pragma unroll
                for (int nt = 0; nt < 4; ++nt) {
                    if (nt == 2) asm volatile("" ::: "memory");
#pragma unroll
                    for (int q = 0; q < 4; ++q) {
                        const int d = nt * 32 + 8 * q + 4 * h;
                        const f32x4 g4 = *(const f32x4*)(kg + 4 * ho + nt * 32 + 8 * q);
                        *(LAS u32x2*)(krow + d) = (u32x2){pk2(acc[0][nt][4 * q] * rk * g4.x, acc[0][nt][4 * q + 1] * rk * g4.y), pk2(acc[0][nt][4 * q + 2] * rk * g4.z, acc[0][nt][4 * q + 3] * rk * g4.w)};
                    }
                }
                asm volatile("" ::: "memory");
#pragma unroll
                for (int j = 0; j < 4; ++j) {
                    const int i0 = 16 * h + 4 * j;
                    const f32x4 ga = *(const f32x4*)(kg + 16 * ho + 128 + 4 * j), gb = *(const f32x4*)(kg + 16 * ho + 160 + 4 * j);
                    const f32x4 csA = *(const f32x4*)(CS + ((size_t)m * 32 + i0) * 2), csB = *(const f32x4*)(CS + ((size_t)m * 32 + i0 + 2) * 2);
                    const f32x4 pa4 = *(const f32x4*)(kpr + 4 * j), pb4 = *(const f32x4*)(kpr + 32 + 4 * j);
                    const float x10 = pa4.x * rk * ga.x, x11 = pa4.y * rk * ga.y, x12 = pa4.z * rk * ga.z, x13 = pa4.w * rk * ga.w;
                    const float x20 = pb4.x * rk * gb.x, x21 = pb4.y * rk * gb.y, x22 = pb4.z * rk * gb.z, x23 = pb4.w * rk * gb.w;
                    *(LAS u32x2*)(krow + 128 + i0) = (u32x2){pk2(x10 * csA.x - x20 * csA.y, x11 * csA.z - x21 * csA.w), pk2(x12 * csB.x - x22 * csB.y, x13 * csB.z - x23 * csB.w)};
                    *(LAS u32x2*)(krow + 160 + i0) = (u32x2){pk2(x20 * csA.x + x10 * csA.y, x21 * csA.z + x11 * csA.w), pk2(x22 * csB.x + x12 * csB.y, x23 * csB.z + x13 * csB.w)};
                }
                asm volatile("s_waitcnt lgkmcnt(0)" ::: "memory");
                { const int m0w = pm * 256 + wid * 32, s0 = m0w % SEQ;
                  unsigned char* gdst = (unsigned char*)(Kb + ((size_t)(b * NH + hd) * SEQ + s0) * QKD);
#pragma unroll
                  for (int k = 0; k < 12; ++k) { const int off = (k * 64 + lane) * 16, row = off / 384, col = off - row * 384; *(u32x4*)(gdst + off) = *(const LAS u32x4*)(er + row * EROWB + col); } }
            } else {
                LAS unsigned char* er = lds + wid * (32 * EROWB);
                const int pk_ = (lm & ~15) + swap23(lm & 15);
#pragma unroll
                for (int nt = 0; nt < 4; ++nt)
#pragma unroll
                    for (int r = 0; r < 16; ++r) { const int dv = nt * 32 + (r & 3) + 8 * (r >> 2) + 4 * h; *(LAS bf16_t*)(er + dv * 80 + pk_ * 2) = f2bf(acc[0][nt][r] * rkv); }
                asm volatile("s_waitcnt lgkmcnt(0)" ::: "memory");
                { const int s0 = (pm * 256 + wid * 32) % SEQ;
                  unsigned char* gdst = (unsigned char*)(VT + (size_t)(b * NH + hd) * VD * SEQ + s0);
#pragma unroll
                  for (int k = 0; k < 8; ++k) { const int idx = k * 64 + lane, dv = idx >> 2, sg = idx & 3; *(u32x4*)(gdst + (size_t)dv * SEQ * 2 + sg * 16) = *(const LAS u32x4*)(er + dv * 80 + sg * 16); } }
            }
            asm volatile("s_waitcnt lgkmcnt(0)" ::: "memory"); __syncthreads();
        }
    }
    for (int it = blockIdx.x * 8 + wid; it < NB * NG * NSEG; it += gridDim.x * 8) ssm_item<false>(p, lds + wid * 8704, it, lane);
}

constexpr int KROWB = 400, VROWB = 144, KT_BYTES = 64 * KROWB, ASTAGE = KT_BYTES + 128 * VROWB;
static_assert(2 * ASTAGE <= LDS_BYTES, "attention stages fit LDS");
#define ATT_QK4(S0, S1, kslot, k0) do { _Pragma("unroll") for (int ks = (k0); ks < (k0) + 4; ++ks) { \
            const bf16x8 kf0 = *(const LAS bf16x8*)(lds + (kslot) + koff + ks * 32), kf1 = *(const LAS bf16x8*)(lds + (kslot) + koff + 32 * KROWB + ks * 32); \
            S0 = MFMA32(kf0, qf[ks], S0); S1 = MFMA32(kf1, qf[ks], S1); } } while (0)
#define ATT_ZERO(S0, S1) do { _Pragma("unroll") for (int r = 0; r < 16; ++r) { S0[r] = 0.f; S1[r] = 0.f; } } while (0)
#define ATT_SM1(S0, S1) \
        float mx = S0[0]; \
        _Pragma("unroll") for (int r = 0; r < 16; ++r) { mx = fmaxf(mx, S0[r]); mx = fmaxf(mx, S1[r]); } \
        mx = fmaxf(mx, __shfl_xor(mx, 32)); \
        const float m_new = fmaxf(m_run, mx); const float alpha = __builtin_amdgcn_exp2f(m_run - m_new); m_run = m_new;
#define ATT_SM2(S0, S1) \
        float ls = 0.f; \
        _Pragma("unroll") for (int r = 0; r < 16; ++r) { const float e0 = __builtin_amdgcn_exp2f(S0[r] - m_new), e1 = __builtin_amdgcn_exp2f(S1[r] - m_new); S0[r] = e0; S1[r] = e1; ls += e0 + e1; } \
        l_run = l_run * alpha + ls;
#define ATT_SM3(S0, S1) \
        _Pragma("unroll") for (int d = 0; d < 4; ++d) _Pragma("unroll") for (int r = 0; r < 16; ++r) o[d][r] *= alpha; \
        bf16x8 pf[4]; \
        { u32x4 pk; pk.x = pk2(S0[0], S0[1]); pk.y = pk2(S0[2], S0[3]); pk.z = pk2(S0[4], S0[5]); pk.w = pk2(S0[6], S0[7]); pf[0] = __builtin_bit_cast(bf16x8, pk); \
          pk.x = pk2(S0[8], S0[9]); pk.y = pk2(S0[10], S0[11]); pk.z = pk2(S0[12], S0[13]); pk.w = pk2(S0[14], S0[15]); pf[1] = __builtin_bit_cast(bf16x8, pk); \
          pk.x = pk2(S1[0], S1[1]); pk.y = pk2(S1[2], S1[3]); pk.z = pk2(S1[4], S1[5]); pk.w = pk2(S1[6], S1[7]); pf[2] = __builtin_bit_cast(bf16x8, pk); \
          pk.x = pk2(S1[8], S1[9]); pk.y = pk2(S1[10], S1[11]); pk.z = pk2(S1[12], S1[13]); pk.w = pk2(S1[14], S1[15]); pf[3] = __builtin_bit_cast(bf16x8, pk); }
#define ATT_PV2(vslot, d0) do { _Pragma("unroll") for (int d = (d0); d < (d0) + 2; ++d) _Pragma("unroll") for (int kk = 0; kk < 4; ++kk) { \
            const bf16x8 vf = *(const LAS bf16x8*)(lds + (vslot) + voff + d * 32 * VROWB + kk * 32); o[d] = MFMA32(vf, pf[kk], o[d]); } } while (0)
#define ATT_SB __builtin_amdgcn_sched_barrier(0)
#define ATT_TILE(S0, S1, T0, T1, kslot, vslot, MASKED) do { \
        if (MASKED) { _Pragma("unroll") for (int r = 0; r < 16; ++r) { S0[r] = -INFINITY; S1[r] = -INFINITY; } } \
        ATT_ZERO(T0, T1); ATT_QK4(T0, T1, kslot, 0); \
        ATT_SM1(S0, S1) ATT_SB; \
        ATT_QK4(T0, T1, kslot, 4); \
        ATT_SM2(S0, S1) ATT_SB; \
        ATT_QK4(T0, T1, kslot, 8); \
        ATT_SM3(S0, S1) ATT_SB; \
        ATT_PV2(vslot, 0); ATT_SB; ATT_PV2(vslot, 2); } while (0)
DI void attn_unit(PP p, LAS unsigned char* lds, int b, int hd, int qb) {
    unsigned char* ws = p->ws;
    const int tid = tid_(), lane = tid & 63, wid = __builtin_amdgcn_readfirstlane(tid >> 6), h = lane >> 5, lm = lane & 31;
    const bf16_t* Qb = (const bf16_t*)(ws + OFF_Q) + (size_t)(b * NH + hd) * SEQ * QKD;
    const char* Kb = (const char*)((const bf16_t*)(ws + OFF_K) + (size_t)(b * NH + hd) * SEQ * QKD);
    const char* Vb = (const char*)((const bf16_t*)(ws + OFF_VT) + (size_t)(b * NH + hd) * VD * SEQ);
    const int sq = qb * 256 + wid * 32 + lm;
    bf16x8 qf[12];
#pragma unroll
    for (int ks = 0; ks < 12; ++ks) qf[ks] = *(const bf16x8*)(Qb + (size_t)sq * QKD + ks * 16 + 8 * h);
    const int ntiles = 4 * qb + 4, my_last = 4 * qb + (wid >> 1);
    unsigned ksrc[4], vsrc[3];
#pragma unroll
    for (int i = 0; i < 4; ++i) { const int byte = 1024 * (wid + 8 * i) + 16 * lane, row = byte / KROWB, cb = byte % KROWB; ksrc[i] = (unsigned)(row * (QKD * 2) + (cb < QKD * 2 ? cb : 0)); }
#pragma unroll
    for (int i = 0; i < 3; ++i) { const int byte = 1024 * (wid + 8 * i) + 16 * lane, row = byte / VROWB, cb = byte % VROWB; vsrc[i] = (unsigned)(row * (SEQ * 2) + (cb < 128 ? cb : 0)); }
#define ATT_DMAK(j, slot) do { const char* kb_ = Kb + (size_t)(j) * 64 * QKD * 2; _Pragma("unroll") for (int i = 0; i < 4; ++i) if (wid + 8 * i < 25) \
        __builtin_amdgcn_global_load_lds((const unsigned*)(kb_ + ksrc[i]), (LAS unsigned*)(lds + (slot) * ASTAGE + 1024 * (wid + 8 * i)), 16, 0, 0); } while (0)
#define ATT_DMAV(j, slot) do { const char* vb_ = Vb + (size_t)(j) * 128; _Pragma("unroll") for (int i = 0; i < 3; ++i) if (wid + 8 * i < 18) \
        __builtin_amdgcn_global_load_lds((const unsigned*)(vb_ + vsrc[i]), (LAS unsigned*)(lds + (slot) * ASTAGE + KT_BYTES + 1024 * (wid + 8 * i)), 16, 0, 0); } while (0)
    f32x16 o[4];
#pragma unroll
    for (int d = 0; d < 4; ++d)
#pragma unroll
        for (int r = 0; r < 16; ++r) o[d][r] = 0.f;
    float m_run = -INFINITY, l_run = 0.f;
    const int koff = lm * KROWB + h * 16, voff = KT_BYTES + lm * VROWB + h * 16;
    f32x16 sA0, sA1, sB0, sB1;
    ATT_DMAK(0, 0); ATT_DMAK(1, 1); ATT_DMAV(0, 0);
    __syncthreads();
    ATT_ZERO(sA0, sA1); ATT_QK4(sA0, sA1, 0, 0); ATT_QK4(sA0, sA1, 0, 4); ATT_QK4(sA0, sA1, 0, 8);
    asm volatile("s_waitcnt lgkmcnt(0)" ::: "memory");
    __syncthreads();
#pragma unroll 1
    for (int j = 0; j < ntiles; j += 2) {
        if (j + 2 < ntiles) ATT_DMAK(j + 2, 0);
        ATT_DMAV(j + 1, 1);
        ATT_TILE(sA0, sA1, sB0, sB1, ASTAGE, 0, j > my_last);
        asm volatile("s_waitcnt lgkmcnt(0)" ::: "memory");
        __syncthreads();
        if (j + 3 < ntiles) ATT_DMAK(j + 3, 1);
        if (j + 2 < ntiles) ATT_DMAV(j + 2, 0);
        ATT_TILE(sB0, sB1, sA0, sA1, 0, ASTAGE, j + 1 > my_last);
        asm volatile("s_waitcnt lgkmcnt(0)" ::: "memory");
        __syncthreads();
    }
#undef ATT_DMAK
#undef ATT_DMAV
    const float inv = 1.0f / (l_run + __shfl_xor(l_run, 32));
    LAS unsigned char* er = lds + wid * (32 * 144);
    const float invs = inv * ASCALE;
#pragma unroll
    for (int d = 0; d < 4; ++d)
#pragma unroll
        for (int q = 0; q < 4; ++q) *(LAS unsigned*)(er + lm * 144 + (d * 32 + 8 * q + 4 * h)) = pk4f8(o[d][4 * q] * invs, o[d][4 * q + 1] * invs, o[d][4 * q + 2] * invs, o[d][4 * q + 3] * invs);
    asm volatile("s_waitcnt lgkmcnt(0)" ::: "memory");
    {
        unsigned char* gdst = ws + OFF_ATT + ((size_t)b * SEQ + (sq - lm)) * 1024 + hd * VD;
#pragma unroll
        for (int k = 0; k < 4; ++k) { const int idx = k * 64 + lane, row = idx >> 3, c16 = idx & 7; *(u32x4*)(gdst + (size_t)row * 1024 + c16 * 16) = *(const LAS u32x4*)(er + row * 144 + c16 * 16); }
    }
    asm volatile("s_waitcnt lgkmcnt(0)" ::: "memory");
    __syncthreads();
}
template <bool ATT, bool SSM>
DI void phase3(PP p, LAS unsigned char* lds) {
    const int tid = tid_(); const int wid = tid >> 6, lane = tid & 63;
    if (ATT) for (int w = blockIdx.x; w < 256; w += gridDim.x) {
        const int bh = (w & 7) * 2 + ((w >> 3) & 1), pi = w >> 4;
#pragma unroll 1
        for (int uu = 0; uu < 2; ++uu) attn_unit(p, lds, bh >> 3, bh & 7, uu ? pi : 31 - pi);
    }
    if (SSM) {
        const int t2 = tid_(), wid2 = t2 >> 6, lane2 = t2 & 63;
        for (int it = blockIdx.x * 8 + wid2; it < NB * NG * NSEG; it += gridDim.x * 8) ssm_item<true>(p, lds + wid2 * 8704, it, lane2);
    }
}

struct EpiMla {
    const bf16_t* SG; bf16_t* TMP;
    DI void operator()(const PgAcc& acc, const PgUnit& u, int wr, int wc, int fr, int fq) const {
        const int pm = u.i0, pn = u.i1;
        u32x4 gb[8][2];
#pragma unroll
        for (int q = 0; q < 8 + 2; ++q) {
            if (q < 8) {
                const int row = pm * 256 + (q >> 2) * 128 + wr * 64 + (q & 3) * 16 + fr;
#pragma unroll
                for (int bj = 0; bj < 2; ++bj) gb[q][bj] = *(const u32x4*)(SG + (size_t)row * 4096 + 2048 + pn * 256 + bj * 128 + wc * 32 + 8 * fq);
            }
            if (q >= 2) {
                const int s = q - 2, ai = s >> 2, m = s & 3;
                const int row = pm * 256 + ai * 128 + wr * 64 + m * 16 + fr;
#pragma unroll
                for (int bj = 0; bj < 2; ++bj) {
                    const int col = pn * 256 + bj * 128 + wc * 32 + 8 * fq;
                    const u32x4 g = gb[s][bj];
                    const f32x4 v0 = acc[ai][bj][m][0] * (1.0f / (ASCALE * WSCALE)), v1 = acc[ai][bj][m][1] * (1.0f / (ASCALE * WSCALE));
                    const u32x4 o = {pk2(v0[0] * bf2f(g.x & 0xffffu), v0[1] * bf2f(g.x >> 16)), pk2(v0[2] * bf2f(g.y & 0xffffu), v0[3] * bf2f(g.y >> 16)),
                                     pk2(v1[0] * bf2f(g.z & 0xffffu), v1[1] * bf2f(g.z >> 16)), pk2(v1[2] * bf2f(g.w & 0xffffu), v1[3] * bf2f(g.w >> 16))};
                    *(u32x4*)(TMP + (size_t)row * D + col) = o;
                }
            }
        }
    }
};
DI void phase4(PP p, LAS unsigned char* lds) {
    unsigned char* ws = p->ws;
    const EpiMla E{(const bf16_t*)(ws + OFF_SG), (bf16_t*)(ws + OFF_TMP)};
    const DenseOrder S{(const char*)(ws + OFF_ATT), (const char*)(ws + OFF_WMLA), 1024, T / 256, D / 256, (T / 256) * (D / 256), (int)gridDim.x, (int)blockIdx.x};
    pg_gemm_phase<true, true, false>(lds, 1024, S, E);
}
struct EpiGlu {
    const bf16_t* SG; const bf16_t* TMP; bf16_t* MRG;
    DI void operator()(const PgAcc& acc, const PgUnit& u, int wr, int wc, int fr, int fq) const {
        const int pm = u.i0, pn = u.i1;
        u32x2 gb[8][2], tb[8][2];
#pragma unroll
        for (int q = 0; q < 8 + 2; ++q) {
            if (q < 8) {
                const int row = pm * 256 + (q >> 2) * 128 + wr * 64 + (q & 3) * 16 + fr;
#pragma unroll
                for (int bj = 0; bj < 2; ++bj) { const int col = pn * 128 + bj * 64 + wc * 16 + 4 * fq; gb[q][bj] = *(const u32x2*)(SG + (size_t)row * 4096 + col); tb[q][bj] = *(const u32x2*)(TMP + (size_t)row * D + col); }
            }
            if (q >= 2) {
                const int s = q - 2, ai = s >> 2, m = s & 3;
                const int row = pm * 256 + ai * 128 + wr * 64 + m * 16 + fr;
#pragma unroll
                for (int bj = 0; bj < 2; ++bj) {
                    const int col = pn * 128 + bj * 64 + wc * 16 + 4 * fq;
                    const u32x2 g = gb[s][bj], t = tb[s][bj];
                    const f32x4 v = acc[ai][bj][m][0] * (1.0f / (WSCALE * SSCALE)), gt = acc[ai][bj][m][1] * (1.0f / (WSCALE * SSCALE));
                    const float r0 = bf2f(t.x & 0xffffu) + bf2f(g.x & 0xffffu) * v[0] * sigmoidq_(gt[0]), r1 = bf2f(t.x >> 16) + bf2f(g.x >> 16) * v[1] * sigmoidq_(gt[1]);
                    const float r2 = bf2f(t.y & 0xffffu) + bf2f(g.y & 0xffffu) * v[2] * sigmoidq_(gt[2]), r3 = bf2f(t.y >> 16) + bf2f(g.y >> 16) * v[3] * sigmoidq_(gt[3]);
                    *(unsigned*)((unsigned char*)MRG + (size_t)row * D + col) = pk4f8(r0 * MSCALE, r1 * MSCALE, r2 * MSCALE, r3 * MSCALE);
                }
            }
        }
    }
};
struct DepOrder5 {
    DenseOrder p4; const char* A; const char* B; int KB;
    DI bool next(int i, PgUnit& u) const {
        PgUnit v; if (!p4.next(i >> 1, v)) return false;
        const int pm = v.i0, pn = 2 * v.i1 + (i & 1);
        u.a = A + (size_t)pm * 256 * KB; u.b = B + (size_t)pn * 256 * KB; u.gidx = nullptr; u.nvalid = 256; u.i0 = pm; u.i1 = pn; u.i2 = 0; u.i3 = 0; return true;
    }
};
DI void phase5(PP p, LAS unsigned char* lds) {
    unsigned char* ws = p->ws;
    const EpiGlu E{(const bf16_t*)(ws + OFF_SG), (const bf16_t*)(ws + OFF_TMP), (bf16_t*)(ws + OFF_MRG)};
    const DenseOrder S4{(const char*)(ws + OFF_ATT), (const char*)(ws + OFF_WMLA), 1024, T / 256, D / 256, (T / 256) * (D / 256), (int)gridDim.x, (int)blockIdx.x};
    const DepOrder5 S{S4, (const char*)(ws + OFF_YSSM), (const char*)(ws + OFF_WVG), 1024};
    pg_gemm_phase<false, true, false>(lds, 1024, S, E);
}
struct EpiOut {
    const float* x; float* out; unsigned char* X1F8; float* SSQ2;
    DI void operator()(const PgAcc& acc, const PgUnit& u, int wr, int wc, int fr, int fq) const {
        const int pm = u.i0, pn = u.i1;
        f32x4 xb[8][2][2];
#pragma unroll
        for (int q = 0; q < 8 + 2; ++q) {
            if (q < 8) {
                const int row = pm * 256 + (q >> 2) * 128 + wr * 64 + (q & 3) * 16 + fr;
#pragma unroll
                for (int bj = 0; bj < 2; ++bj)
#pragma unroll
                    for (int n = 0; n < 2; ++n) xb[q][bj][n] = *(const f32x4*)(x + (size_t)row * D + pn * 256 + bj * 128 + wc * 32 + n * 16 + 4 * fq);
            }
            if (q >= 2) {
                const int s = q - 2, ai = s >> 2, m = s & 3;
                const int row = pm * 256 + ai * 128 + wr * 64 + m * 16 + fr;
#pragma unroll
                for (int bj = 0; bj < 2; ++bj) {
                    float ssq = 0.f;
#pragma unroll
                    for (int n = 0; n < 2; ++n) {
                        const int col = pn * 256 + bj * 128 + wc * 32 + n * 16 + 4 * fq;
                        const f32x4 r = xb[s][bj][n] + acc[ai][bj][m][n] * (1.0f / (MSCALE * WSCALE));
                        ssq += r[0] * r[0] + r[1] * r[1] + r[2] * r[2] + r[3] * r[3];
                        *(f32x4*)(out + (size_t)row * D + col) = r;
                        *(unsigned*)(X1F8 + (size_t)row * D + col) = pk4f8(r[0], r[1], r[2], r[3]);
                    }
                    ssq += __shfl_xor(ssq, 16); ssq += __shfl_xor(ssq, 32);
                    if (fq == 0) SSQ2[(size_t)row * 64 + pn * 8 + bj * 4 + wc] = ssq;
                }
            }
        }
    }
};
DI void phase6(PP p, LAS unsigned char* lds) {
    unsigned char* ws = p->ws;
    const EpiOut E{p->in[0], p->out, ws + OFF_X1F8, (float*)(ws + OFF_SSQ2)};
    const DenseOrder S{(const char*)(ws + OFF_MRG), (const char*)(ws + OFF_WOUT), D, T / 256, D / 256, (T / 256) * (D / 256), (int)gridDim.x, (int)blockIdx.x};
    pg_gemm_phase<false, true, false>(lds, D, S, E);
}

template <bool TOPK>
DI void phase7(PP p, LAS unsigned char* lds) {
    unsigned char* ws = p->ws;
    const int tid = tid_(), lane = tid & 63, wid = tid >> 6, h = lane >> 5, lm = lane & 31;
    const float* x1 = p->out; const float* WRT = (const float*)(ws + OFF_WRT); const float* SSQ2 = (const float*)(ws + OFF_SSQ2);
    const float* bias = p->in[24];
    int* CNT = (int*)(ws + OFF_CNT); int* LIST = (int*)(ws + OFF_LIST); float* ROWW = (float*)(ws + OFF_ROWW); int* TPOS = (int*)(ws + OFF_TPOS);
    float* RSTD2 = (float*)(ws + OFF_RSTD2); float* RS2 = (float*)(ws + OFF_RS2);
    LAS float* part = (LAS float*)lds;
    LAS float* sc = (LAS float*)(lds + 65536);
    LAS float* rs = (LAS float*)(lds + 65536 + 8320);
    LAS float* selb = (LAS float*)(lds + 76800) + wid * 64;
    const float mybias = bias[lane];
    for (int u = blockIdx.x; u < T / 32; u += gridDim.x) {
        const int t0 = u * 32;
        f32x4 acc_[2][4];
#pragma unroll
        for (int mt = 0; mt < 2; ++mt)
#pragma unroll
            for (int nt = 0; nt < 4; ++nt) acc_[mt][nt] = (f32x4){0.f, 0.f, 0.f, 0.f};
        const int li = lane & 15, kk = lane >> 4;
        const float* xr = x1 + (size_t)(t0 + li) * D + wid * 256 + 4 * kk;
        const float* wq = WRT + ((size_t)(wid * 16) * 4 + kk) * 256 + li * 4;
        const int rotk = (wid * 3 + (int)blockIdx.x) & 15;
        f32x4 xa0[2], xa1[2], xa2[2], xa3[2], w0[4], w1[4], w2[4], w3[4];
#define RT_LD(xa, w, kb) do { const int kbr_ = ((kb) + rotk) & 15; xa[0] = __builtin_nontemporal_load((const f32x4*)(xr + kbr_ * 16)); xa[1] = __builtin_nontemporal_load((const f32x4*)(xr + (size_t)16 * D + kbr_ * 16)); \
            _Pragma("unroll") for (int nt = 0; nt < 4; ++nt) w[nt] = *(const f32x4*)(wq + (size_t)kbr_ * 1024 + nt * 64); } while (0)
#define RT_SPLIT(a, b, hi, lo) do { u32x4 H_, L_; _Pragma("unroll") for (int q_ = 0; q_ < 2; ++q_) { \
            const float fa0_ = a[2 * q_], fa1_ = a[2 * q_ + 1], fb0_ = b[2 * q_], fb1_ = b[2 * q_ + 1];     \
            const unsigned a0_ = __builtin_bit_cast(unsigned, fa0_), a1_ = __builtin_bit_cast(unsigned, fa1_), b0_ = __builtin_bit_cast(unsigned, fb0_), b1_ = __builtin_bit_cast(unsigned, fb1_); \
            H_[q_] = __builtin_amdgcn_perm(a1_, a0_, 0x07060302u); H_[2 + q_] = __builtin_amdgcn_perm(b1_, b0_, 0x07060302u); \
            L_[q_] = pk2(fa0_ - __builtin_bit_cast(float, a0_ & 0xffff0000u), fa1_ - __builtin_bit_cast(float, a1_ & 0xffff0000u)); \
            L_[2 + q_] = pk2(fb0_ - __builtin_bit_cast(float, b0_ & 0xffff0000u), fb1_ - __builtin_bit_cast(float, b1_ & 0xffff0000u)); } \
            hi = __builtin_bit_cast(bf16x8, H_); lo = __builtin_bit_cast(bf16x8, L_); } while (0)
#define RT_MM2(xa, xb, wa, wb) do { bf16x8 xh_[2], xl_[2]; _Pragma("unroll") for (int mt = 0; mt < 2; ++mt) RT_SPLIT(xa[mt], xb[mt], xh_[mt], xl_[mt]); \
            _Pragma("unroll") for (int nt = 0; nt < 4; ++nt) { bf16x8 wh_, wl_; RT_SPLIT(wa[nt], wb[nt], wh_, wl_); \
                _Pragma("unroll") for (int mt = 0; mt < 2; ++mt) { acc_[mt][nt] = __builtin_amdgcn_mfma_f32_16x16x32_bf16(xl_[mt], wh_, acc_[mt][nt], 0, 0, 0); \
                    acc_[mt][nt] = __builtin_amdgcn_mfma_f32_16x16x32_bf16(xh_[mt], wl_, acc_[mt][nt], 0, 0, 0); acc_[mt][nt] = __builtin_amdgcn_mfma_f32_16x16x32_bf16(xh_[mt], wh_, acc_[mt][nt], 0, 0, 0); } } } while (0)
        RT_LD(xa0, w0, 0); RT_LD(xa1, w1, 1); RT_LD(xa2, w2, 2); RT_LD(xa3, w3, 3);
#pragma unroll 1
        for (int kb = 0; kb < 16; kb += 4) {
            RT_MM2(xa0, xa1, w0, w1);
            if (kb + 4 < 16) { RT_LD(xa0, w0, kb + 4); RT_LD(xa1, w1, kb + 5); }
            RT_MM2(xa2, xa3, w2, w3);
            if (kb + 4 < 16) { RT_LD(xa2, w2, kb + 6); RT_LD(xa3, w3, kb + 7); }
        }
#undef RT_LD
#undef RT_SPLIT
#undef RT_MM2
#pragma unroll
        for (int mt = 0; mt < 2; ++mt)
#pragma unroll
            for (int nt = 0; nt < 4; ++nt)
#pragma unroll
                for (int j = 0; j < 4; ++j) part[(wid * 32 + 16 * mt + 4 * kk + j) * 64 + 16 * nt + li] = acc_[mt][nt][j];
        if (tid < 32) { float s = 0.f;
#pragma unroll
            for (int i = 0; i < 64; ++i) s += SSQ2[(size_t)(t0 + tid) * 64 + i];
            const float r_ = 1.0f / sqrtf(s * (1.0f / D) + EPS); rs[tid] = r_; RSTD2[t0 + tid] = r_; }
        __syncthreads();
#pragma unroll
        for (int i = 0; i < 4; ++i) {
            const int idx = tid + NTHREADS * i, tok = idx >> 6, e = idx & 63;
            float s = 0.f;
#pragma unroll
            for (int w = 0; w < 8; ++w) s += part[(w * 32 + tok) * 64 + e];
            sc[tok * 65 + e] = sigmoidf_(s * rs[tok]);
        }
        asm volatile("s_waitcnt lgkmcnt(0)" ::: "memory");
        __syncthreads();
        LAS int* lcnt = (LAS int*)(lds + 78848);
        LAS int* rec = (LAS int*)(lds + 79872);
        if (tid < 64) lcnt[tid] = 0;
        __syncthreads();
#pragma unroll 1
        for (int i = 0; i < (TOPK ? 4 : 0); ++i) {
            const int tok = wid + 8 * i, e = lane, g = lane >> 3;
            const float score = sc[tok * 65 + e];
            const float sel = score + mybias;
            int rg = 0;
#pragma unroll
            for (int d = 1; d < 8; ++d) { const float o = __shfl_xor(sel, d); rg += (o > sel || (o == sel && (e ^ d) < e)) ? 1 : 0; }
            float gs = rg < 2 ? sel : 0.f;
            gs += __shfl_xor(gs, 1); gs += __shfl_xor(gs, 2); gs += __shfl_xor(gs, 4);
            int gr = 0;
#pragma unroll
            for (int d = 1; d < 8; ++d) { const float o = __shfl_xor(gs, 8 * d); gr += (o > gs || (o == gs && (g ^ d) < g)) ? 1 : 0; }
            const bool allowed = gr < 4;
            selb[e] = allowed ? sel : -INFINITY;
            asm volatile("s_waitcnt lgkmcnt(0)" ::: "memory");
            int rk = 0;
#pragma unroll 8
            for (int j = 0; j < 64; ++j) { const float o = selb[j]; rk += (o > sel || (o == sel && j < e)) ? 1 : 0; }
            const bool picked = allowed && rk < 8;
            float wsum = picked ? score : 0.f;
#pragma unroll
            for (int o = 1; o < 64; o <<= 1) wsum += __shfl_xor(wsum, o);
            if (picked) {
                const int ls = __hip_atomic_fetch_add(lcnt + e, 1, __ATOMIC_RELAXED, __HIP_MEMORY_SCOPE_WORKGROUP);
                LAS int* r_ = rec + (tok * 8 + rk) * 4;
                r_[0] = e; r_[1] = ls; r_[2] = __builtin_bit_cast(int, score * (2.5f / wsum));
            }
            asm volatile("s_waitcnt lgkmcnt(0)" ::: "memory");
        }
        __syncthreads();
        if (TOPK && tid < 64) lcnt[64 + tid] = atomicAdd(&CNT[tid * 64], lcnt[tid]);
        __syncthreads();
        if (TOPK && tid < 256) {
            const int tok = tid >> 3, t = t0 + tok;
            const LAS int* r_ = rec + tid * 4;
            const int e = r_[0], slot = lcnt[64 + e] + r_[1];
            LIST[(size_t)e * T + slot] = t; ROWW[(size_t)e * T + slot] = __builtin_bit_cast(float, r_[2]); RS2[(size_t)e * T + slot] = rs[tok]; TPOS[(size_t)t * 8 + (tid & 7)] = (e << 16) | slot;
        }
        asm volatile("s_waitcnt lgkmcnt(0)" ::: "memory");
        __syncthreads();
    }
}

DI void moe_tables(PP p, LAS int* tb) {
    const int* CNT = (const int*)(p->ws + OFF_CNT);
    const int tid = tid_();
    if (tid < NE) tb[256 + tid] = CNT[tid * 64];
    __syncthreads();
    if (tid == 0) { int tacc = 0, racc = 0;
        for (int e = 0; e < NE; ++e) { const int c = tb[256 + e]; tb[e] = tacc; tb[128 + e] = racc; tacc += (c + 255) >> 8; racc += c; }
        tb[NE] = tacc; tb[128 + NE] = T * TOPK; tb[NE + 1] = tacc + T / 256; tb[256 + NE] = T; }
    __syncthreads();
}
constexpr int MOE_MAXU = 64;
struct MoeOrder {
    LAS const int* tb; const int* list; const char* A; const char* B; size_t bstride; int KB, lognn, G, c; bool gather; LAS const int* ut;
    DI void locate(int i, int& e, int& mi, int& ni, int& nvalid, int& rbase) const {
        const int ntr = tb[NE + 1];
        int tr; e = -1;
        if ((G & 7) == 0) {
            const int x = c & 7, lo = (x * ntr) >> 3, hi = ((x + 1) * ntr) >> 3, Lx = i * (G >> 3) + (c >> 3);
            if (Lx >= ((hi - lo) << lognn)) return;
            tr = lo + (Lx >> lognn); ni = Lx & ((1 << lognn) - 1);
        } else {
            const int L = i * G + c; if (L >= (ntr << lognn)) return;
            tr = L >> lognn; ni = L & ((1 << lognn) - 1);
        }
        int ee = 0;
#pragma unroll 1
        for (int st_ = 64; st_ >= 1; st_ >>= 1) { const int c_ = ee + st_; if (c_ <= NE && tb[c_] <= tr) ee = c_; }
        e = ee; mi = tr - tb[ee]; nvalid = min(256, tb[256 + ee] - mi * 256); rbase = tb[128 + ee] + mi * 256;
    }
    DI void build(LAS int* utw) const {
        const int i = tid_();
        if (i < MOE_MAXU) { int e, mi = 0, ni = 0, nvalid = 0, rbase = 0; locate(i, e, mi, ni, nvalid, rbase);
            *(LAS u32x4*)(utw + i * 8) = (u32x4){(unsigned)e, (unsigned)mi, (unsigned)ni, (unsigned)nvalid}; utw[i * 8 + 4] = rbase; }
        asm volatile("s_waitcnt lgkmcnt(0)" ::: "memory");
        __syncthreads();
    }
    DI bool next(int i, PgUnit& u) const {
        int e, mi, ni, nvalid, rbase;
        if (i < MOE_MAXU) { const u32x4 d = *(const LAS u32x4*)(ut + i * 8); e = (int)d.x; mi = (int)d.y; ni = (int)d.z; nvalid = (int)d.w; rbase = ut[i * 8 + 4]; }
        else locate(i, e, mi, ni, nvalid, rbase);
        e = __builtin_amdgcn_readfirstlane(e);
        if (e < 0) return false;
        mi = __builtin_amdgcn_readfirstlane(mi); ni = __builtin_amdgcn_readfirstlane(ni); nvalid = __builtin_amdgcn_readfirstlane(nvalid); rbase = __builtin_amdgcn_readfirstlane(rbase);
        u.b = B + (size_t)e * bstride + (size_t)ni * 256 * KB;
        if (gather) { if (e < NE) { u.a = A; u.gidx = list + (size_t)e * T + mi * 256; } else { u.a = A + (size_t)mi * 256 * KB; u.gidx = nullptr; } }
        else { u.a = A + (size_t)rbase * KB; u.gidx = nullptr; }
        u.nvalid = nvalid; u.i0 = e; u.i1 = mi; u.i2 = ni; u.i3 = rbase; return true;
    }
};
struct EpiGateUp {
    const float* ROWW; const float* RS2; const float* RSTD2; unsigned char* HID8;
    DI void operator()(const PgAcc& acc, const PgUnit& u, int wr, int wc, int fr, int fq) const {
        const int e = u.i0, mi = u.i1, ni = u.i2, rbase = u.i3;
        const int cofs = ni * 128 + wc * 32 + ((fq & 1) ? 16 + 4 * (fq - 1) : 4 * fq);
        const float* r2p = (e < NE) ? RS2 + (size_t)e * T + mi * 256 : RSTD2 + mi * 256;
        const float* rwp = ROWW + (size_t)((e < NE) ? e : 0) * T + mi * 256;
        float r2v[8], rwv[8];
#pragma unroll
        for (int q = 0; q < 8; ++q) { const int rl = (q >> 2) * 128 + wr * 64 + (q & 3) * 16 + fr, rr = rl < u.nvalid ? rl : 0; r2v[q] = r2p[rr]; rwv[q] = rwp[rr]; }
        asm volatile("s_waitcnt vmcnt(0)" ::: "memory");
#pragma unroll
        for (int ai = 0; ai < 2; ++ai)
#pragma unroll
            for (int m = 0; m < 4; ++m) {
                const int rl = ai * 128 + wr * 64 + m * 16 + fr;
                const float r2 = r2v[ai * 4 + m] * (1.0f / WSCALE);
                const float rw = ((e < NE) ? rwv[ai * 4 + m] : 1.0f) * HSCALE;
                unsigned h[2];
#pragma unroll
                for (int bj = 0; bj < 2; ++bj) {
                    const f32x4 g = acc[ai][bj][m][0] * r2, up = acc[ai][bj][m][1] * (r2 * rw);
                    h[bj] = pk4f8(silu_(g[0]) * up[0], silu_(g[1]) * up[1], silu_(g[2]) * up[2], silu_(g[3]) * up[3]);
                }
                const auto s = __builtin_amdgcn_permlane16_swap(h[0], h[1], false, false);
                if (rl < u.nvalid) *(u32x2*)(HID8 + (size_t)(rbase + rl) * DE + cofs) = (u32x2){s[0], s[1]};
            }
    }
};
DI void phase8(PP p, LAS unsigned char* lds) {
    unsigned char* ws = p->ws;
    LAS int* tb = (LAS int*)(lds + PG_STAGE_BYTES);
    moe_tables(p, tb);
    const EpiGateUp E{(const float*)(ws + OFF_ROWW), (const float*)(ws + OFF_RS2), (const float*)(ws + OFF_RSTD2), ws + OFF_HID8};
    const MoeOrder S{tb, (const int*)(ws + OFF_LIST), (const char*)(ws + OFF_X1F8), (const char*)(ws + OFF_WGU8), (size_t)1024 * D, D, 2, (int)gridDim.x, (int)blockIdx.x, true, (LAS const int*)(lds + UT_OFF)};
    S.build((LAS int*)(lds + UT_OFF));
    pg_gemm_phase<false, true, true>(lds, D, S, E);
}
struct EpiDown {
    unsigned char* Y;
    DI void operator()(const PgAcc& acc, const PgUnit& u, int wr, int wc, int fr, int fq) const {
        const int ni = u.i2, rbase = u.i3;
        const int cofs = ni * 256 + wc * 64 + ((fq & 1) ? 32 + 8 * (fq - 1) : 8 * fq);
#pragma unroll
        for (int ai = 0; ai < 2; ++ai)
#pragma unroll
            for (int m = 0; m < 4; ++m) {
                const int rl = ai * 128 + wr * 64 + m * 16 + fr;
                const f32x4 a0 = acc[ai][0][m][0] * (YSCALE / (WSCALE * HSCALE)), a1 = acc[ai][0][m][1] * (YSCALE / (WSCALE * HSCALE));
                const f32x4 b0 = acc[ai][1][m][0] * (YSCALE / (WSCALE * HSCALE)), b1 = acc[ai][1][m][1] * (YSCALE / (WSCALE * HSCALE));
                const unsigned x0 = pk4f8(a0[0], a0[1], a0[2], a0[3]), x1 = pk4f8(a1[0], a1[1], a1[2], a1[3]);
                const unsigned z0 = pk4f8(b0[0], b0[1], b0[2], b0[3]), z1 = pk4f8(b1[0], b1[1], b1[2], b1[3]);
                const auto s0 = __builtin_amdgcn_permlane16_swap(x0, z0, false, false), s1 = __builtin_amdgcn_permlane16_swap(x1, z1, false, false);
                if (rl < u.nvalid) *(u32x4*)(Y + (size_t)(rbase + rl) * D + cofs) = (u32x4){s0[0], s1[0], s0[1], s1[1]};
            }
    }
};
DI void phase9(PP p, LAS unsigned char* lds) {
    unsigned char* ws = p->ws;
    LAS int* tb = (LAS int*)(lds + PG_STAGE_BYTES);
    const EpiDown E{ws + OFF_Y};
    const MoeOrder S{tb, nullptr, (const char*)(ws + OFF_HID8), (const char*)(ws + OFF_WDN8), (size_t)D * DE, DE, 3, (int)gridDim.x, (int)blockIdx.x, false, (LAS const int*)(lds + UT_OFF)};
    S.build((LAS int*)(lds + UT_OFF));
    pg_gemm_phase<true, true, true>(lds, DE, S, E);
}
DI void phase10(PP p, LAS unsigned char* lds) {
    unsigned char* ws = p->ws;
    LAS int* tb = (LAS int*)(lds + PG_STAGE_BYTES);
    const int tid = tid_(); const int lane = tid & 63, wid = tid >> 6;
    const int* TPOS = (const int*)(ws + OFF_TPOS); const unsigned char* Y = ws + OFF_Y; float* out = p->out;
    int t = blockIdx.x * 8 + wid;
    int tp[8];
    if (t < T) {
#pragma unroll
        for (int k = 0; k < 8; ++k) tp[k] = TPOS[(size_t)t * 8 + k];
    }
    for (; t < T; t += gridDim.x * 8) {
        const unsigned char* rp[9];
#pragma unroll
        for (int k = 0; k < 8; ++k) rp[k] = Y + ((size_t)tb[128 + (tp[k] >> 16)] + (size_t)(tp[k] & 0xffff)) * D + lane * 4;
        rp[8] = Y + ((size_t)T * TOPK + t) * D + lane * 4;
        const int tn = t + gridDim.x * 8;
        if (tn < T) {
#pragma unroll
            for (int k = 0; k < 8; ++k) tp[k] = TPOS[(size_t)tn * 8 + k];
        }
        unsigned v[8][9]; f32x4 o[8];
        f32x4* op = (f32x4*)(out + (size_t)t * D) + lane;
#pragma unroll
        for (int c = 0; c < 8; ++c) {
#pragma unroll
            for (int k = 0; k < 9; ++k) v[c][k] = __builtin_nontemporal_load((const unsigned*)(rp[k] + c * 256));
            o[c] = __builtin_nontemporal_load(op + c * 64);
        }
#pragma unroll
        for (int c = 0; c < 8; ++c) {
            float a0 = 0.f, a1 = 0.f, a2 = 0.f, a3 = 0.f;
#pragma unroll
            for (int k = 0; k < 9; ++k) { const int x_ = (int)v[c][k];
                const f32x2 lo = __builtin_amdgcn_cvt_pk_f32_fp8(x_, false), hi = __builtin_amdgcn_cvt_pk_f32_fp8(x_, true);
                a0 += lo[0]; a1 += lo[1]; a2 += hi[0]; a3 += hi[1]; }
            f32x4 r = o[c];
            r.x += a0 * (1.0f / YSCALE); r.y += a1 * (1.0f / YSCALE); r.z += a2 * (1.0f / YSCALE); r.w += a3 * (1.0f / YSCALE);
            __builtin_nontemporal_store(r, op + c * 64);
        }
    }
}

DI unsigned xb_ld(unsigned* p)              { return __hip_atomic_load(p, __ATOMIC_RELAXED, __HIP_MEMORY_SCOPE_AGENT); }
DI unsigned xb_add(unsigned* p, unsigned v) { return __hip_atomic_fetch_add(p, v, __ATOMIC_RELAXED, __HIP_MEMORY_SCOPE_AGENT); }
template <bool USE_CG>
DI void flat_barrier(unsigned* bar, unsigned& epoch, cg::grid_group& grid) {
    asm volatile("s_waitcnt vmcnt(0)" ::: "memory");
    __syncthreads();
    if (USE_CG) grid.sync();
    else {
        epoch += 1u;
        if (threadIdx.x == 0) {
            __builtin_amdgcn_fence(__ATOMIC_RELEASE, "agent");
            asm volatile("s_waitcnt vmcnt(0)" ::: "memory");
            (void)xb_add(bar, 1u);
            const unsigned want = epoch * gridDim.x;
            unsigned sp = 0u;
            while (xb_ld(bar) < want) { __builtin_amdgcn_s_sleep(1); if (++sp > (1u << 24)) break; }
            __builtin_amdgcn_fence(__ATOMIC_ACQUIRE, "agent");
            asm volatile("s_waitcnt vmcnt(0)" ::: "memory");
        }
        __syncthreads();
    }
}
#define XB_TMO      128
#define XB_XCNT(j)  (256  + 64 * (j))
#define XB_XSUB(j)  (1280 + 64 * (j))
#define XB_XGEN(j)  (2304 + 64 * (j))
#define XB_TOP      3328
#define XB_TOPGEN   3392
#define XCD_BAR_WORDS 3456
#define XB_SPIN_CAP (1u << 18)
DI unsigned xb_xcc_id() { return (unsigned)__builtin_amdgcn_s_getreg((3 << 11) | 20) & 0xFu; }
#define XB_SPIN(cond, bar) do { unsigned _sp = 0; while (cond) { __builtin_amdgcn_s_sleep(1); \
    if ((++_sp & 255u) == 0u) { if (xb_ld(&(bar)[XB_TMO])) break; if (_sp > XB_SPIN_CAP) { atomicAdd(&(bar)[XB_TMO], 1u); break; } } } } while (0)
DI void xcd_barrier_complete(unsigned* bar, unsigned x, unsigned& nloc, unsigned& nx) {
    const unsigned G = gridDim.x;
    unsigned sum, cnt, mine, sp = 0u;
    for (;;) {
        sum = 0u; cnt = 0u; mine = 0u;
#pragma unroll 1
        for (unsigned j = 0; j < 16; ++j) { const unsigned c = xb_ld(&bar[XB_XCNT(j)]); sum += c; cnt += (c > 0u) ? 1u : 0u; mine = (j == x) ? c : mine; }
        if (sum == G) break;
        __builtin_amdgcn_s_sleep(1);
        if ((++sp & 255u) == 0u) { if (xb_ld(&bar[XB_TMO])) break; if (sp > XB_SPIN_CAP) { atomicAdd(&bar[XB_TMO], 1u); break; } }
    }
    nloc = mine > 0u ? mine : 1u; nx = cnt > 0u ? cnt : 1u;
}
__device__ __attribute__((noinline)) void xcd_barrier_leader(unsigned* bar, volatile LAS unsigned* st) {
    const unsigned x = xb_xcc_id();
    unsigned nloc = st[0], nx = st[1];
    if (nloc == 0u) { xcd_barrier_complete(bar, x, nloc, nx); st[0] = nloc; st[1] = nx; }
    const unsigned old = xb_add(&bar[XB_XSUB(x)], 1u);
    const unsigned gen = old / nloc;
    if (old + 1u == (gen + 1u) * nloc) {
        __builtin_amdgcn_fence(__ATOMIC_RELEASE, "agent");
        asm volatile("s_waitcnt vmcnt(0)" ::: "memory");
        const unsigned og = xb_add(&bar[XB_TOP], 1u);
        const unsigned tg = og / nx;
        if (og + 1u == (tg + 1u) * nx) xb_add(&bar[XB_TOPGEN], 1u);
        else XB_SPIN(xb_ld(&bar[XB_TOPGEN]) == tg, bar);
        __builtin_amdgcn_fence(__ATOMIC_ACQUIRE, "agent");
        xb_add(&bar[XB_XGEN(x)], 1u);
        asm volatile("s_waitcnt vmcnt(0)" ::: "memory");
    } else {
        XB_SPIN(xb_ld(&bar[XB_XGEN(x)]) == gen, bar);
        __builtin_amdgcn_fence(__ATOMIC_ACQUIRE, "agent");
        asm volatile("s_waitcnt vmcnt(0)" ::: "memory");
    }
}
#ifndef ONLY_PHASE
#define PH_ON(n) true
#else
#define PH_ON(n) ((n) == ONLY_PHASE)
#endif
DI void code_prefetch(int nlines) {
    const int l = (int)threadIdx.x - 64;
    if (l >= 0 && l < nlines) {
        unsigned long long pc; asm volatile("s_getpc_b64 %0" : "=s"(pc));
        const char* a = (const char*)(pc & ~127ull) + (size_t)l * 128;
        int t_; asm volatile("global_load_dword %0, %1, off\n\ts_waitcnt vmcnt(0)" : "=v"(t_) : "v"(a) : "memory");
    }
}
extern __shared__ __attribute__((aligned(16))) unsigned char smem_raw[];
__global__ void __launch_bounds__(NTHREADS, 2) hybrid_fwd(Params p_unused) {
    LAS unsigned char* lds = (LAS unsigned char*)smem_raw;
    cg::grid_group grid = cg::this_grid();
    PP p = (PP)__builtin_amdgcn_kernarg_segment_ptr();
    unsigned epoch = 0u; bool first_seam = true;
    if (blockIdx.x == 0) { for (int i = threadIdx.x; i < XCD_BAR_WORDS; i += NTHREADS) __hip_atomic_store((unsigned*)(p->ws + OFF_XBAR) + i, 0u, __ATOMIC_RELAXED, __HIP_MEMORY_SCOPE_AGENT); }
#define RUN_PHASE(n, call) do { asm volatile("" : "+s"(p)); asm volatile("" : "+s"(lds)); if (PH_ON(n)) { call; } } while (0)
#define SEAM() SEAMN(256)
#define SEAMN(NL) do { if (first_seam) { code_prefetch(NL); flat_barrier<true>((unsigned*)(p->ws + OFF_BAR), epoch, grid); first_seam = false; \
            if (threadIdx.x == 0) { *(volatile LAS unsigned*)(lds + XBST_OFF) = 0u; *(volatile LAS unsigned*)(lds + XBST_OFF + 4) = 0u; (void)xb_add((unsigned*)(p->ws + OFF_XBAR) + XB_XCNT(xb_xcc_id()), 1u); } } \
        else { asm volatile("s_waitcnt vmcnt(0)" ::: "memory"); __syncthreads(); if (threadIdx.x == 0) xcd_barrier_leader((unsigned*)(p->ws + OFF_XBAR), (volatile LAS unsigned*)(lds + XBST_OFF)); else code_prefetch(NL); __syncthreads(); } } while (0)
    code_prefetch(256);
    RUN_PHASE(0, phase0(p, lds));            SEAM();
#ifdef DUP_0
    RUN_PHASE(0, phase0(p, lds));            SEAM();
#endif
    RUN_PHASE(1, phase1(p, lds));       SEAM();
#ifdef DUP_1
    RUN_PHASE(1, phase1(p, lds));       SEAM();
#endif
    RUN_PHASE(2, phase2(p, lds));       SEAM();
#ifdef DUP_2
    RUN_PHASE(2, phase2(p, lds));       SEAM();
#endif
    RUN_PHASE(3, (phase3<true, true>(p, lds)));       SEAM();
#ifdef DUP_3A
    RUN_PHASE(3, (phase3<true, false>(p, lds)));       SEAM();
#endif
#ifdef DUP_3S
    RUN_PHASE(3, (phase3<false, true>(p, lds)));       SEAM();
#endif
    RUN_PHASE(4, phase4(p, lds));       asm volatile("s_waitcnt vmcnt(0)" ::: "memory"); __syncthreads(); code_prefetch(128);
#ifdef EMPTY_SEAMS
    SEAM(); SEAM(); SEAM(); SEAM();
#endif
    RUN_PHASE(5, phase5(p, lds));       SEAM();
    RUN_PHASE(6, phase6(p, lds));       SEAM();
#ifdef DUP_4
    RUN_PHASE(4, phase4(p, lds));       SEAM();
#endif
#ifdef DUP_5
    RUN_PHASE(5, phase5(p, lds));       SEAM();
#endif
#ifdef DUP_6
    RUN_PHASE(6, phase6(p, lds));       SEAM();
#endif
#ifdef DUP_456
    RUN_PHASE(4, phase4(p, lds));       SEAM();
    RUN_PHASE(5, phase5(p, lds));       SEAM();
    RUN_PHASE(6, phase6(p, lds));       SEAM();
#endif
#ifdef PRE_7
    RUN_PHASE(7, phase7<false>(p, lds));       SEAM();
#endif
    RUN_PHASE(7, phase7<true>(p, lds));       SEAM();
#ifdef DUP_7
    if (blockIdx.x < 8) ((int*)(p->ws + OFF_CNT))[blockIdx.x * 512 + threadIdx.x] = 0;
    SEAM();
    RUN_PHASE(7, phase7<true>(p, lds));       SEAM();
#endif
    RUN_PHASE(8, phase8(p, lds));       SEAMN(160);
#ifdef DUP_8
    RUN_PHASE(8, phase8(p, lds));       SEAM();
#endif
    RUN_PHASE(9, phase9(p, lds));       SEAMN(32);
#ifdef DUP_9
    RUN_PHASE(9, phase9(p, lds));       SEAM();
#endif
    RUN_PHASE(10, phase10(p, lds));
#undef RUN_PHASE
#undef SEAM
#undef SEAMN
}

extern "C" void kernel_launch(void* const* d_in, const int* in_sizes, int n_in, void* d_out, int out_size, void* d_ws, size_t ws_size, hipStream_t stream) {
    static int grid_blocks = 0;
    if (grid_blocks == 0) {
        if (n_in != 31 || out_size != T * D || ws_size < WS_NEED) { fprintf(stderr, "kernel_launch: unexpected problem (n_in %d out %d ws %zu need %zu)\n", n_in, out_size, ws_size, (size_t)WS_NEED); grid_blocks = -1; return; }
        int dev = 0, cus = 0, per_cu = 0;
        hipGetDevice(&dev);
        hipDeviceGetAttribute(&cus, hipDeviceAttributeMultiprocessorCount, dev);
        if (hipFuncSetAttribute((const void*)hybrid_fwd, hipFuncAttributeMaxDynamicSharedMemorySize, LDS_BYTES) != hipSuccess) { fprintf(stderr, "kernel_launch: hipFuncSetAttribute failed\n"); grid_blocks = -1; return; }
        hipOccupancyMaxActiveBlocksPerMultiprocessor(&per_cu, (const void*)hybrid_fwd, NTHREADS, LDS_BYTES);
        if (per_cu < 1) { fprintf(stderr, "kernel_launch: occupancy query says %d blocks/CU\n", per_cu); grid_blocks = -1; return; }
        grid_blocks = cus;
    }
    if (grid_blocks < 0) return;
    Params p{};
    for (int i = 0; i < 31; ++i) p.in[i] = (const float*)d_in[i];
    p.out = (float*)d_out; p.ws = (unsigned char*)d_ws;
    for (int i = 0; i < 32; ++i) p.inv_freq[i] = std::pow(10000.0, -(double)i / 32.0);
    p.nseq = 11; p.use_grid_sync = 1;
    void* args[] = {&p};
    hipError_t e = hipLaunchCooperativeKernel((const void*)hybrid_fwd, dim3(grid_blocks), dim3(NTHREADS), args, LDS_BYTES, stream);
    if (e != hipSuccess) fprintf(stderr, "cooperative launch failed: %s (grid %d)\n", hipGetErrorString(e), grid_blocks);
}
```
